# Optimizing an MI355X kernel written in HIP

```python
import math
import jax, jax.numpy as jnp
from jax import lax
import numpy as np

D_MODEL = 2048
BATCH = 2
SEQ = 8192
DEPTH = 2
DEC_BATCH = 16
DEC_SEQ = 2048
PAST_LEN = 128

D_RNN = D_MODEL // 2
N_BLOCKS = 16
BLOCK_W = D_RNN // N_BLOCKS
CONV_RG = 4
RG_C = 8.0
H_GLA = 4
DK_TOT = D_MODEL // 4
DV_TOT = D_MODEL // 2
DK_HEAD = DK_TOT // H_GLA
DV_HEAD = DV_TOT // H_GLA
GATE_RANK = 16
GATE_NORM = 16.0
CHUNK = 64
D_FF = 3 * D_MODEL
CONV_FF = 3
D_IN = 2 * D_RNN + 2 * DK_TOT + 2 * DV_TOT + 2 * GATE_RANK + 2 * D_MODEL
ALPHA = (2.0 * DEPTH) ** 0.25
BETA = (8.0 * DEPTH) ** -0.25
EPS = 1e-5

kernel_name = "hybrid_rglru_gla_convffn_encoder"


def _layer_norm(x, g, b):
    xf = x.astype(jnp.float32)
    mu = jnp.mean(xf, axis=-1, keepdims=True)
    var = jnp.mean(jnp.square(xf - mu), axis=-1, keepdims=True)
    return ((xf - mu) * lax.rsqrt(var + EPS) * g + b).astype(x.dtype)


def _dwconv(x, w, b, pad_lo, pad_hi):
    s = x.shape[1]
    xp = jnp.pad(x, ((0, 0), (pad_lo, pad_hi), (0, 0)))
    out = b
    for j in range(w.shape[0]):
        out = out + w[j] * xp[:, j:j + s]
    return out


def _lin_combine(c1, c2):
    a1, b1 = c1
    a2, b2 = c2
    return a1 * a2, a2 * b1 + b2


def _rglru_dir(xc, wa, ba, wx, bx, lam, reverse):
    bsz, s, w = xc.shape
    xb = xc.reshape(bsz, s, N_BLOCKS, BLOCK_W)
    r = jax.nn.sigmoid(jnp.einsum('bsni,nij->bsnj', xb, wa).reshape(bsz, s, w) + ba)
    i = jax.nn.sigmoid(jnp.einsum('bsni,nij->bsnj', xb, wx).reshape(bsz, s, w) + bx)
    log_a = -RG_C * r * jax.nn.softplus(-lam)
    a = jnp.exp(log_a)
    u = jnp.sqrt(-jnp.expm1(2.0 * log_a)) * (i * xc)
    _, h = lax.associative_scan(_lin_combine, (a, u), axis=1, reverse=reverse)
    return h


def _gla_dir(q, k, v, g):
    bsz, h, s, dk = q.shape
    dv = v.shape[-1]
    n = s // CHUNK
    q = q.reshape(bsz, h, n, CHUNK, dk)
    k = k.reshape(bsz, h, n, CHUNK, dk)
    v = v.reshape(bsz, h, n, CHUNK, dv)
    gc = jnp.cumsum(g.reshape(bsz, h, n, CHUNK, dk), axis=3)
    g_last = gc[:, :, :, -1]
    q_d = q * jnp.exp(gc)
    k_d = k * jnp.exp(-gc)
    mask = jnp.tril(jnp.ones((CHUNK, CHUNK), dtype=bool))
    att = jnp.einsum('bhncd,bhnsd->bhncs', q_d, k_d)
    att = jnp.where(mask, att, 0.0)
    o_intra = jnp.einsum('bhncs,bhnsv->bhncv', att, v)
    k_end = k * jnp.exp(g_last[:, :, :, None, :] - gc)
    kv = jnp.einsum('bhncd,bhncv->bhndv', k_end, v)
    dec = jnp.exp(g_last)

    def step(state, inp):
        d_n, kv_n = inp
        return d_n[..., None] * state + kv_n, state

    init = jnp.zeros((bsz, h, dk, dv), dtype=q.dtype)
    _, s_prev = lax.scan(step, init, (jnp.moveaxis(dec, 2, 0), jnp.moveaxis(kv, 2, 0)))
    s_prev = jnp.moveaxis(s_prev, 0, 2)
    o_inter = jnp.einsum('bhncd,bhndv->bhncv', q_d, s_prev)
    return (o_intra + o_inter).reshape(bsz, h, s, dv)


def _token_mixer(x, w_in, b_in, conv_rg_w, conv_rg_b, rg_wa, rg_ba, rg_wx, rg_bx, rg_lam,
                 gla_wg2, gla_bg, gla_norm_w, w_proj_a, w_proj_b, w_out):
    bsz, s, _ = x.shape
    z = x @ w_in + b_in
    sizes = [D_RNN, D_RNN, DK_TOT, DK_TOT, DV_TOT, DV_TOT, GATE_RANK, GATE_RANK, D_MODEL, D_MODEL]
    offs = [int(o) for o in np.cumsum(sizes)[:-1]]
    z_rx, z_rg, z_q, z_k, z_v, z_og, z_gf, z_gb, z_ma, z_mb = jnp.split(z, offs, axis=-1)

    xa = _dwconv(z_rx, conv_rg_w, conv_rg_b, CONV_RG // 2, CONV_RG - 1 - CONV_RG // 2).astype(jnp.float32)
    h_a = (_rglru_dir(xa, rg_wa[0], rg_ba[0], rg_wx[0], rg_bx[0], rg_lam[0], False)
           + _rglru_dir(xa, rg_wa[1], rg_ba[1], rg_wx[1], rg_bx[1], rg_lam[1], True))
    y_a = (jax.nn.gelu(z_rg) * h_a.astype(x.dtype)) @ w_proj_a

    def heads(t, dh):
        return t.reshape(bsz, s, H_GLA, dh).transpose(0, 2, 1, 3).astype(jnp.float32)

    q = heads(z_q, DK_HEAD) * (DK_HEAD ** -0.5)
    k = heads(z_k, DK_HEAD)
    v = heads(z_v, DV_HEAD)
    g_f = heads(jax.nn.log_sigmoid(z_gf @ gla_wg2[0] + gla_bg[0]) / GATE_NORM, DK_HEAD)
    g_b = heads(jax.nn.log_sigmoid(z_gb @ gla_wg2[1] + gla_bg[1]) / GATE_NORM, DK_HEAD)
    o = _gla_dir(q, k, v, g_f) + jnp.flip(
        _gla_dir(jnp.flip(q, 2), jnp.flip(k, 2), jnp.flip(v, 2), jnp.flip(g_b, 2)), 2)
    o = o * lax.rsqrt(jnp.mean(jnp.square(o), axis=-1, keepdims=True) + EPS) * gla_norm_w
    o = o.transpose(0, 2, 1, 3).reshape(bsz, s, DV_TOT).astype(x.dtype)
    y_b = (o * jax.nn.silu(z_og)) @ w_proj_b

    merged = jax.nn.sigmoid(z_ma) * y_a + jax.nn.sigmoid(z_mb) * y_b
    return merged @ w_out


def _conv_ffn(x, w_up, conv_ff_w, conv_ff_b, w_down):
    u = x @ w_up
    u_g, u_v = jnp.split(u, 2, axis=-1)
    hdn = jax.nn.gelu(_dwconv(u_g, conv_ff_w, conv_ff_b, CONV_FF // 2, CONV_FF // 2)) * u_v
    return hdn @ w_down


def _trunk(x, ln_in_g, ln_in_b, w_in, b_in, conv_rg_w, conv_rg_b, rg_wa, rg_ba, rg_wx, rg_bx,
           rg_lam, gla_wg2, gla_bg, gla_norm_w, w_proj_a, w_proj_b, w_out, ln_mix_g, ln_mix_b,
           w_up, conv_ff_w, conv_ff_b, w_down, ln_ffn_g, ln_ffn_b):
    x = _layer_norm(x, ln_in_g, ln_in_b)
    for l in range(DEPTH):
        mix = _token_mixer(x, w_in[l], b_in[l], conv_rg_w[l], conv_rg_b[l], rg_wa[l], rg_ba[l],
                           rg_wx[l], rg_bx[l], rg_lam[l], gla_wg2[l], gla_bg[l], gla_norm_w[l],
                           w_proj_a[l], w_proj_b[l], w_out[l])
        x = _layer_norm(ALPHA * x + mix, ln_mix_g[l], ln_mix_b[l])
        ff = _conv_ffn(x, w_up[l], conv_ff_w[l], conv_ff_b[l], w_down[l])
        x = _layer_norm(ALPHA * x + ff, ln_ffn_g[l], ln_ffn_b[l])
    return x


def setup_inputs(seed: int = 0) -> dict:
    key = jax.random.key(seed)
    ks = jax.random.split(key, 32)
    f32 = jnp.float32

    def nrm(k, shape, scale):
        return jax.random.normal(k, shape, dtype=f32) * scale

    a0 = jax.random.uniform(ks[10], (DEPTH, 2, D_RNN), dtype=f32, minval=0.9, maxval=0.999)
    return {
        "x_prompt": nrm(ks[0], (BATCH, SEQ, D_MODEL), 1.0),
        "x_sample": nrm(ks[1], (DEC_BATCH, DEC_SEQ, D_MODEL), 1.0),
        "ln_in_g": 1.0 + nrm(ks[2], (D_MODEL,), 0.02),
        "ln_in_b": nrm(ks[3], (D_MODEL,), 0.02),
        "w_in": nrm(ks[4], (DEPTH, D_MODEL, D_IN), D_MODEL ** -0.5),
        "b_in": nrm(ks[5], (DEPTH, D_IN), 0.02),
        "conv_rg_w": nrm(ks[6], (DEPTH, CONV_RG, D_RNN), CONV_RG ** -0.5),
        "conv_rg_b": nrm(ks[7], (DEPTH, D_RNN), 0.02),
        "rg_wa": nrm(ks[8], (DEPTH, 2, N_BLOCKS, BLOCK_W, BLOCK_W), BLOCK_W ** -0.5),
        "rg_ba": nrm(ks[9], (DEPTH, 2, D_RNN), 0.02),
        "rg_wx": nrm(ks[11], (DEPTH, 2, N_BLOCKS, BLOCK_W, BLOCK_W), BLOCK_W ** -0.5),
        "rg_bx": nrm(ks[12], (DEPTH, 2, D_RNN), 0.02),
        "rg_lam": jnp.log(a0) - jnp.log1p(-a0),
        "gla_wg2": nrm(ks[13], (DEPTH, 2, GATE_RANK, DK_TOT), GATE_RANK ** -0.5),
        "gla_bg": nrm(ks[14], (DEPTH, 2, DK_TOT), 0.1),
        "gla_norm_w": 1.0 + nrm(ks[15], (DEPTH, DV_HEAD), 0.02),
        "w_proj_a": nrm(ks[16], (DEPTH, D_RNN, D_MODEL), BETA * D_RNN ** -0.5),
        "w_proj_b": nrm(ks[17], (DEPTH, DV_TOT, D_MODEL), BETA * DV_TOT ** -0.5),
        "w_out": nrm(ks[18], (DEPTH, D_MODEL, D_MODEL), BETA * D_MODEL ** -0.5),
        "ln_mix_g": 1.0 + nrm(ks[19], (DEPTH, D_MODEL), 0.02),
        "ln_mix_b": nrm(ks[20], (DEPTH, D_MODEL), 0.02),
        "w_up": nrm(ks[21], (DEPTH, D_MODEL, 2 * D_FF), D_MODEL ** -0.5),
        "conv_ff_w": nrm(ks[22], (DEPTH, CONV_FF, D_FF), CONV_FF ** -0.5),
        "conv_ff_b": nrm(ks[23], (DEPTH, D_FF), 0.02),
        "w_down": nrm(ks[24], (DEPTH, D_FF, D_MODEL), BETA * D_FF ** -0.5),
        "ln_ffn_g": 1.0 + nrm(ks[25], (DEPTH, D_MODEL), 0.02),
        "ln_ffn_b": nrm(ks[26], (DEPTH, D_MODEL), 0.02),
    }


def reference(x_prompt, x_sample, ln_in_g, ln_in_b, w_in, b_in, conv_rg_w, conv_rg_b, rg_wa,
              rg_ba, rg_wx, rg_bx, rg_lam, gla_wg2, gla_bg, gla_norm_w, w_proj_a, w_proj_b,
              w_out, ln_mix_g, ln_mix_b, w_up, conv_ff_w, conv_ff_b, w_down, ln_ffn_g, ln_ffn_b):
    y_prompt = _trunk(x_prompt, ln_in_g, ln_in_b, w_in, b_in, conv_rg_w, conv_rg_b, rg_wa, rg_ba,
                      rg_wx, rg_bx, rg_lam, gla_wg2, gla_bg, gla_norm_w, w_proj_a, w_proj_b, w_out,
                      ln_mix_g, ln_mix_b, w_up, conv_ff_w, conv_ff_b, w_down, ln_ffn_g, ln_ffn_b)
    y_sample = _trunk(x_sample, ln_in_g, ln_in_b, w_in, b_in, conv_rg_w, conv_rg_b, rg_wa, rg_ba,
                      rg_wx, rg_bx, rg_lam, gla_wg2, gla_bg, gla_norm_w, w_proj_a, w_proj_b, w_out,
                      ln_mix_g, ln_mix_b, w_up, conv_ff_w, conv_ff_b, w_down, ln_ffn_g, ln_ffn_b)
    return (y_prompt, y_sample)
```

```cpp
#include <hip/hip_runtime.h>
#include <hip/hip_cooperative_groups.h>
#include <cstdio>
#include <cstdint>
namespace cg = cooperative_groups;

#ifndef PHMASK
#define PHMASK 0xFFFF
#endif
#define EN(k) (((PHMASK) >> (k)) & 1)
#ifndef WGM_BIG
#define WGM_BIG 5
#endif
#ifndef WGM_SMALL
#define WGM_SMALL 4
#endif
#ifndef LNR
#define LNR 4
#endif
#ifndef REPMASK
#define REPMASK 0
#endif
#ifndef GLA_DBG
#define GLA_DBG 0
#endif
#ifndef ONE_LAUNCH
#define ONE_LAUNCH 1
#endif

#define LAS __attribute__((address_space(3)))
typedef unsigned short bf16_t;
typedef short bf16x8 __attribute__((ext_vector_type(8)));
typedef float f32x4 __attribute__((ext_vector_type(4)));
typedef float f32x2 __attribute__((ext_vector_type(2)));
typedef unsigned u32x4 __attribute__((ext_vector_type(4)));
typedef unsigned u32x2 __attribute__((ext_vector_type(2)));

constexpr int D = 2048, TALL = 49152, NG = 3, TG = 16384, LDZ = 9248, NZ = 9472, DRNN = 1024, DFF = 6144, DEPTH = 2;
constexpr int ZC_RX = 0, ZC_RG = 1024, ZC_Q = 2048, ZC_K = 2560, ZC_V = 3072, ZC_OG = 4096, ZC_MA = 5120, ZC_MB = 7168, ZC_GF = 9216;
constexpr float ALPHA = 1.41421356237f, EPS = 1e-5f;
constexpr int PH_PER_LAYER = 11, PH_PER_GROUP = 1 + DEPTH * PH_PER_LAYER, NPH = 1 + NG * PH_PER_GROUP;

constexpr size_t MiB = 1u << 20;
constexpr size_t WIN_B = (size_t)NZ * D * 2, WUP_B = (size_t)2 * DFF * D * 2, WDN_B = (size_t)D * DFF * 2, WOUT_B = (size_t)D * D * 2, WPA_B = (size_t)D * DRNN * 2;
constexpr size_t RGW_B = (size_t)2 * 2 * 16 * 64 * 64 * 2, BIASP_B = 65536;
constexpr size_t LW_WIN = 0, LW_WUP = LW_WIN + WIN_B, LW_WDN = LW_WUP + WUP_B, LW_WOUT = LW_WDN + WDN_B, LW_WPA = LW_WOUT + WOUT_B, LW_WPB = LW_WPA + WPA_B,
                 LW_RGW = LW_WPB + WPA_B, LW_BIAS = LW_RGW + RGW_B, LW_SIZE = LW_BIAS + BIASP_B;
constexpr size_t WS_XN = DEPTH * LW_SIZE, WS_CARRY = WS_XN + 64 * MiB, WS_R = WS_CARRY + 2 * MiB;
constexpr size_t WS_Z = WS_R, WS_HA = WS_R + 289 * MiB, WS_OB = WS_HA + 32 * MiB, WS_OF = WS_OB + 32 * MiB, WS_OK = WS_OF + 32 * MiB;
constexpr size_t WS_QDG = WS_OK + 32 * MiB, WS_KDG = WS_QDG + 32 * MiB, WS_KETG = WS_KDG + 32 * MiB, WS_DECG = WS_KETG + 32 * MiB, WS_ATTG = WS_DECG + 1 * MiB;
constexpr size_t WS_U = WS_R, WS_HDN = WS_R + 384 * MiB, WS_CTL = WS_R + 576 * MiB, CTL_BYTES = 65536, WS_STATS = WS_CTL + CTL_BYTES  , WS_END = WS_STATS + (size_t)TG * 8;
static_assert((size_t)TG * LDZ * 2 == 289 * MiB, "z size");
static_assert(LW_SIZE % 256 == 0, "align");

constexpr int LDS_BYTES = 147456;

typedef __bf16 bf16x2_t __attribute__((ext_vector_type(2)));
__device__ __forceinline__ unsigned cvt_pk_bf16(float lo, float hi) { f32x2 v = {lo, hi}; bf16x2_t b = __builtin_convertvector(v, bf16x2_t); return __builtin_bit_cast(unsigned, b); }
__device__ __forceinline__ float bflo(unsigned w) { return __uint_as_float(w << 16); }
__device__ __forceinline__ float bfhi(unsigned w) { return __uint_as_float(w & 0xffff0000u); }
__device__ __forceinline__ float bf2f(unsigned short h) { return __uint_as_float((unsigned)h << 16); }
__device__ __forceinline__ unsigned short f2bf(float f) { return (unsigned short)(cvt_pk_bf16(f, 0.f) & 0xffffu); }
__device__ __forceinline__ float sigmoid_f(float x) { return __builtin_amdgcn_rcpf(1.f + __expf(-x)); }
__device__ __forceinline__ float gelu_tanh(float v) { return v * sigmoid_f(1.5957691216f * (v + 0.044715f * v * v * v)); }
__device__ __forceinline__ float wave_sum(float v) {
#pragma unroll
    for (int o = 1; o < 64; o <<= 1) v += __shfl_xor(v, o);
    return v;
}
__device__ __forceinline__ void unpack8(u32x4 w, float (&f)[8]) {
    f[0] = bflo(w.x); f[1] = bfhi(w.x); f[2] = bflo(w.y); f[3] = bfhi(w.y); f[4] = bflo(w.z); f[5] = bfhi(w.z); f[6] = bflo(w.w); f[7] = bfhi(w.w);
}
__device__ __forceinline__ u32x4 pack8(const float (&f)[8]) {
    u32x4 w; w.x = cvt_pk_bf16(f[0], f[1]); w.y = cvt_pk_bf16(f[2], f[3]); w.z = cvt_pk_bf16(f[4], f[5]); w.w = cvt_pk_bf16(f[6], f[7]); return w;
}
#define WG_BARRIER() __syncthreads()

namespace pg8 {
constexpr int BM = 256, BK = 64, HALF = 128, HTB = HALF * BK * 2, STAGE_BYTES = 8 * HTB, NXCD = 8, WGM = 8;
__host__ __device__ __forceinline__ int lds_byte(int r, int c) { const int st = (r >> 4) * 2 + (c >> 5), rr = r & 15, cc = c & 31, ob = rr * 64 + cc * 2; return st * 1024 + (ob ^ (((ob >> 9) & 1) << 5)); }
__host__ __device__ __forceinline__ void stage_rc(int b, int& R, int& C) { const int st = b / 1024, sb = b % 1024, swz = sb ^ (((sb >> 9) & 1) << 5); R = (st >> 1) * 16 + swz / 64; C = (st & 1) * 32 + (swz % 64) / 2; }
__host__ __device__ __forceinline__ int perm32(int rho) { const int n = rho >> 4, i = rho & 15; return 8 * (i >> 2) + 4 * n + (i & 3); }

struct Unit { int pm, pn; };
struct Gemm { const bf16_t* A; int lda; const bf16_t* Bt; int M, N, K; };

struct StaticOrder {
    int nM, nN, nwg, G, c, wgm;
    __device__ void init(int M, int N, int G_, int c_, int wgm_ = WGM) { nM = M / BM; nN = N / BM; nwg = nM * nN; G = G_; c = c_; wgm = wgm_; }
    __device__ bool next(int i, Unit& u) const {
        const long L = (long)i * G + c; if (L >= nwg) return false;
        int wgid = (int)L; { const int q = nwg / NXCD, r = nwg % NXCD, xcd = wgid % NXCD, off = wgid / NXCD; wgid = (xcd < r ? xcd * (q + 1) : r * (q + 1) + (xcd - r) * q) + off; }
        const int nig = wgm * nN, gid = wgid / nig, fm = gid * wgm, gsz = (nM - fm) < wgm ? (nM - fm) : wgm;
        u.pm = fm + ((wgid % nig) % gsz); u.pn = (wgid % nig) / gsz; return true;
    }
};

template <class Epi, class Sched>
__device__ __forceinline__ void gemm_phase(LAS unsigned char* lds, const Gemm g, const Sched& S, const Epi& E, const int tid) {
    const int wid = __builtin_amdgcn_readfirstlane(tid >> 6), lane = tid & 63, wr = wid >> 2, wc = wid & 3, fr = lane & 15, fq = lane >> 4;
    const int K = g.K, nt = K / BK, lda = g.lda;
    unsigned voffA[2], voffB[2];
#pragma unroll
    for (int i = 0; i < 2; ++i) { int R, C; stage_rc(tid * 16 + i * 8192, R, C); const int Rb = Epi::PERM ? ((R & ~31) + perm32(R & 31)) : R;
        voffA[i] = (unsigned)(R * lda + C) * 2u; voffB[i] = (unsigned)(Rb * K + C) * 2u; }
    const size_t kstep = (size_t)(BK * 2);
    const size_t hstepA = (size_t)HALF * lda * 2, hstepB = (size_t)HALF * K * 2;
    const size_t tstepA = 2 * hstepA, tstepB = 2 * hstepB;
    const unsigned ldsw = (unsigned)wid * 1024u;
    const int aoff = lds_byte(wr * 64 + fr, fq * 8), boff = lds_byte(wc * 32 + fr, fq * 8);
#define PG8_SA(b, h) (((b) * 2 + (h)) * HTB)
#define PG8_SB(b, h) ((4 + (b) * 2 + (h)) * HTB)
#define PG8_STAGE(bufoff, gbase, voff) do { _Pragma("unroll") for (int _i = 0; _i < 2; ++_i) \
        __builtin_amdgcn_global_load_lds((const unsigned*)((const char*)(gbase) + (voff)[_i]), (LAS unsigned*)(lds + (bufoff) + ldsw + _i * 8192), 16, 0, 0); } while (0)
#define PG8_LDA(dst, b, h) do { _Pragma("unroll") for (int m = 0; m < 4; ++m) _Pragma("unroll") for (int k = 0; k < 2; ++k) dst[m][k] = *(const LAS bf16x8*)(lds + PG8_SA(b, h) + aoff + m * 2048 + k * 1024); } while (0)
#define PG8_LDB(dst, b, h) do { _Pragma("unroll") for (int n = 0; n < 2; ++n) _Pragma("unroll") for (int k = 0; k < 2; ++k) dst[n][k] = *(const LAS bf16x8*)(lds + PG8_SB(b, h) + boff + n * 2048 + k * 1024); } while (0)
#define PG8_MMA(ai, bj, At, Bt) do { __builtin_amdgcn_s_setprio(1); _Pragma("unroll") for (int m = 0; m < 4; ++m) _Pragma("unroll") for (int n = 0; n < 2; ++n) _Pragma("unroll") for (int k = 0; k < 2; ++k) \
        acc[ai][bj][m][n] = __builtin_amdgcn_mfma_f32_16x16x32_bf16(Bt[n][k], At[m][k], acc[ai][bj][m][n], 0, 0, 0); __builtin_amdgcn_s_setprio(0); } while (0)
#define PG8_WAIT_V(n) asm volatile("s_waitcnt vmcnt(" #n ")" ::: "memory")
#define PG8_WAIT_L(n) asm volatile("s_waitcnt lgkmcnt(" #n ")" ::: "memory")
#define PG8_BAR __builtin_amdgcn_s_barrier()
#define PG8_SCHED __builtin_amdgcn_sched_barrier(0)
    Unit cur, nxt; int ui = 0;
    if (!S.next(0, cur)) return;
    f32x4 acc[2][2][4][2];
#pragma unroll
    for (int a = 0; a < 2; ++a)
#pragma unroll
        for (int b = 0; b < 2; ++b)
#pragma unroll
            for (int m = 0; m < 4; ++m)
#pragma unroll
                for (int n = 0; n < 2; ++n) acc[a][b][m][n] = (f32x4){0.f, 0.f, 0.f, 0.f};
    bf16x8 At[4][2], B0[2][2], B1[2][2];
    const char* cA = (const char*)g.A + (size_t)cur.pm * tstepA; const char* cB = (const char*)g.Bt + (size_t)cur.pn * tstepB;
    PG8_STAGE(PG8_SB(0, 0), cB, voffB); PG8_STAGE(PG8_SB(0, 1), cB + hstepB, voffB); PG8_STAGE(PG8_SA(0, 0), cA, voffA); PG8_STAGE(PG8_SA(0, 1), cA + hstepA, voffA);
    if (wr == 1) PG8_BAR;
    PG8_WAIT_V(2); PG8_BAR;
    PG8_STAGE(PG8_SB(1, 0), cB + kstep, voffB); PG8_STAGE(PG8_SA(1, 0), cA + kstep, voffA); PG8_STAGE(PG8_SB(1, 1), cB + hstepB + kstep, voffB);
    PG8_WAIT_V(6); PG8_BAR;
    for (;;) {
        const bool has_next = S.next(ui + 1, nxt);
        const char* nA = has_next ? (const char*)g.A + (size_t)nxt.pm * tstepA : cA; const char* nB = has_next ? (const char*)g.Bt + (size_t)nxt.pn * tstepB : cB;
        for (int t = 0; t < nt; t += 2) {
            const bool last = (t == nt - 2);
            const char* a1 = cA + (size_t)(t + 1) * kstep;
            const char* a2 = last ? nA : cA + (size_t)(t + 2) * kstep; const char* b2 = last ? nB : cB + (size_t)(t + 2) * kstep;
            const char* a3 = a2 + kstep; const char* b3 = b2 + kstep;
            PG8_LDB(B0, 0, 0); PG8_LDB(B1, 0, 1); PG8_SCHED; PG8_LDA(At, 0, 0); PG8_STAGE(PG8_SA(1, 1), a1 + hstepA, voffA);
            PG8_WAIT_V(8); PG8_WAIT_L(0); PG8_BAR; PG8_MMA(0, 0, At, B0); PG8_MMA(0, 1, At, B1); PG8_BAR; PG8_SCHED;
            PG8_LDA(At, 0, 1); PG8_STAGE(PG8_SB(0, 0), b2, voffB); PG8_STAGE(PG8_SB(0, 1), b2 + hstepB, voffB); PG8_STAGE(PG8_SA(0, 0), a2, voffA);
            PG8_WAIT_V(8); PG8_WAIT_L(0); PG8_BAR; PG8_MMA(1, 0, At, B0); PG8_MMA(1, 1, At, B1); PG8_BAR; PG8_SCHED;
            PG8_LDB(B0, 1, 0); PG8_LDB(B1, 1, 1); PG8_SCHED; PG8_LDA(At, 1, 0); PG8_STAGE(PG8_SA(0, 1), a2 + hstepA, voffA);
            PG8_WAIT_V(8); PG8_WAIT_L(0); PG8_BAR; PG8_MMA(0, 0, At, B0); PG8_MMA(0, 1, At, B1); PG8_BAR; PG8_SCHED;
            PG8_LDA(At, 1, 1); PG8_STAGE(PG8_SB(1, 0), b3, voffB); PG8_STAGE(PG8_SB(1, 1), b3 + hstepB, voffB); PG8_STAGE(PG8_SA(1, 0), a3, voffA);
            PG8_WAIT_V(8); PG8_WAIT_L(0); PG8_BAR; PG8_MMA(1, 0, At, B0); PG8_MMA(1, 1, At, B1); PG8_BAR; PG8_SCHED;
        }
        if (wr == 0) PG8_BAR;
        E(acc, cur, wr, wc, fr, fq);
        if (!has_next) break;
#pragma unroll
        for (int a = 0; a < 2; ++a)
#pragma unroll
            for (int b = 0; b < 2; ++b)
#pragma unroll
                for (int m = 0; m < 4; ++m)
#pragma unroll
                    for (int n = 0; n < 2; ++n) acc[a][b][m][n] = (f32x4){0.f, 0.f, 0.f, 0.f};
        cur = nxt; cA = nA; cB = nB; ++ui;
        if (wr == 1) PG8_BAR;
    }
    PG8_WAIT_V(0);
    PG8_BAR;
#undef PG8_SA
#undef PG8_SB
#undef PG8_STAGE
#undef PG8_LDA
#undef PG8_LDB
#undef PG8_MMA
#undef PG8_WAIT_V
#undef PG8_WAIT_L
#undef PG8_BAR
#undef PG8_SCHED
}

struct EpiZ {
    static constexpr bool PERM = true;
    bf16_t* Z; const float* bias;
    __device__ __forceinline__ void operator()(const f32x4 (&acc)[2][2][4][2], const Unit& u, int wr, int wc, int fr, int fq) const {
        const int pn = u.pn;
        int mode = 0;
        if (pn == 8 || pn == 9) mode = 2; else if (pn >= 20 && pn < 36) mode = 4;
        const bool tail = (pn == 36);
        if (tail && wc != 0) return;
        const int row0 = u.pm * BM + wr * 64 + fr; const int col0 = pn * BM + wc * 32 + 8 * fq;
#pragma unroll
        for (int bj = 0; bj < 2; ++bj) {
            if (tail && bj == 1) break;
            const f32x4 b0 = *(const f32x4*)(bias + col0 + bj * HALF), b1 = *(const f32x4*)(bias + col0 + bj * HALF + 4);
#pragma unroll
            for (int ai = 0; ai < 2; ++ai)
#pragma unroll
                for (int m = 0; m < 4; ++m) {
                    f32x4 v0 = acc[ai][bj][m][0] + b0, v1 = acc[ai][bj][m][1] + b1;
                    float f[8] = {v0[0], v0[1], v0[2], v0[3], v1[0], v1[1], v1[2], v1[3]};
                    if (mode == 1) {
#pragma unroll
                        for (int e = 0; e < 8; ++e) f[e] = gelu_tanh(f[e]);
                    } else if (mode == 2) {
#pragma unroll
                        for (int e = 0; e < 8; ++e) f[e] *= 0.08838834764831845f;
                    } else if (mode == 3) {
#pragma unroll
                        for (int e = 0; e < 8; ++e) f[e] = f[e] * sigmoid_f(f[e]);
                    } else if (mode == 4) {
#pragma unroll
                        for (int e = 0; e < 8; ++e) f[e] = sigmoid_f(f[e]);
                    }
                    __builtin_nontemporal_store(pack8(f), (u32x4*)(Z + (size_t)(row0 + ai * HALF + m * 16) * LDZ + col0 + bj * HALF));
                }
        }
    }
};
template <bool HAS_ADD> struct EpiGate {
    static constexpr bool PERM = true;
    bf16_t* dst; const bf16_t* gate; const bf16_t* add;
    __device__ __forceinline__ void operator()(const f32x4 (&acc)[2][2][4][2], const Unit& u, int wr, int wc, int fr, int fq) const {
        const int row0 = u.pm * BM + wr * 64 + fr; const int col0 = u.pn * BM + wc * 32 + 8 * fq;
#pragma unroll
        for (int ai = 0; ai < 2; ++ai)
#pragma unroll
          for (int mh = 0; mh < 2; ++mh) {
            u32x4 gv[4][2], av[4][2];
#pragma unroll
            for (int m = 2 * mh; m < 2 * mh + 2; ++m)
#pragma unroll
                for (int bj = 0; bj < 2; ++bj) {
                    const size_t off = (size_t)(row0 + ai * HALF + m * 16) * LDZ + col0 + bj * HALF;
                    gv[m][bj] = *(const u32x4*)(gate + off);
                    if (HAS_ADD) av[m][bj] = *(const u32x4*)(add + off);
                }
#pragma unroll
            for (int m = 2 * mh; m < 2 * mh + 2; ++m)
#pragma unroll
                for (int bj = 0; bj < 2; ++bj) {
                    const size_t off = (size_t)(row0 + ai * HALF + m * 16) * LDZ + col0 + bj * HALF;
                    float gt[8]; unpack8(gv[m][bj], gt);
                    const f32x4 v0 = acc[ai][bj][m][0], v1 = acc[ai][bj][m][1];
                    float f[8] = {v0[0] * gt[0], v0[1] * gt[1], v0[2] * gt[2], v0[3] * gt[3], v1[0] * gt[4], v1[1] * gt[5], v1[2] * gt[6], v1[3] * gt[7]};
                    if (HAS_ADD) { float ad[8]; unpack8(av[m][bj], ad);
#pragma unroll
                        for (int e = 0; e < 8; ++e) f[e] += ad[e]; }
                    *(u32x4*)(dst + off) = pack8(f);
                }
        }
    }
};
template <bool NORM> struct EpiRes {
    static constexpr bool PERM = false;
    float* X; const float* stats; const float* gam; const float* bet; bool dry;
    __device__ __forceinline__ void operator()(const f32x4 (&acc)[2][2][4][2], const Unit& u, int wr, int wc, int fr, int fq) const {
        const int row0 = u.pm * BM + wr * 64 + fr; const int col0 = u.pn * BM + wc * 32 + 4 * fq;
#pragma unroll
        for (int bj = 0; bj < 2; ++bj)
#pragma unroll
            for (int n = 0; n < 2; ++n) {
                const int col = col0 + bj * HALF + n * 16;
                f32x4 gg = {1.f, 1.f, 1.f, 1.f}, bb = {0.f, 0.f, 0.f, 0.f};
                if (NORM) { gg = *(const f32x4*)(gam + col); bb = *(const f32x4*)(bet + col); }
#pragma unroll
                for (int ai = 0; ai < 2; ++ai) {
                    f32x4 xv[4]; f32x2 st[4];
#pragma unroll
                    for (int m = 0; m < 4; ++m) { xv[m] = *(const f32x4*)(X + (size_t)(row0 + ai * HALF + m * 16) * D + col);
                        if (NORM) st[m] = *(const f32x2*)(stats + 2 * (row0 + ai * HALF + m * 16)); }
#pragma unroll
                    for (int m = 0; m < 4; ++m) {
                        f32x4 x = xv[m];
                        if (NORM) x = (x - st[m].x) * st[m].y * gg + bb;
                        if (!dry) *(f32x4*)(X + (size_t)(row0 + ai * HALF + m * 16) * D + col) = x * ALPHA + acc[ai][bj][m][n];
                    }
                }
            }
    }
};
struct EpiBf16 {
    static constexpr bool PERM = true;
    bf16_t* O; int ld;
    __device__ __forceinline__ void operator()(const f32x4 (&acc)[2][2][4][2], const Unit& u, int wr, int wc, int fr, int fq) const {
        const int row0 = u.pm * BM + wr * 64 + fr; const int col0 = u.pn * BM + wc * 32 + 8 * fq;
#pragma unroll
        for (int ai = 0; ai < 2; ++ai)
#pragma unroll
            for (int m = 0; m < 4; ++m)
#pragma unroll
                for (int bj = 0; bj < 2; ++bj) {
                    const f32x4 v0 = acc[ai][bj][m][0], v1 = acc[ai][bj][m][1];
                    u32x4 w; w.x = cvt_pk_bf16(v0[0], v0[1]); w.y = cvt_pk_bf16(v0[2], v0[3]); w.z = cvt_pk_bf16(v1[0], v1[1]); w.w = cvt_pk_bf16(v1[2], v1[3]);
                    __builtin_nontemporal_store(w, (u32x4*)(O + (size_t)(row0 + ai * HALF + m * 16) * ld + col0 + bj * HALF));
                }
    }
};
}


#define XB_TMO      128
#define XB_XCNT(j)  (256  + 64 * (j))
#define XB_XSUB(j)  (1280 + 64 * (j))
#define XB_XGEN(j)  (2304 + 64 * (j))
#define XB_TOP      3328
#define XB_TOPGEN   3392
#define XCD_BAR_WORDS 3456
#define XB_SPIN_CAP (1u << 22)
__device__ __forceinline__ unsigned xb_ld(unsigned* p)              { return __hip_atomic_load(p, __ATOMIC_RELAXED, __HIP_MEMORY_SCOPE_AGENT); }
__device__ __forceinline__ unsigned xb_add(unsigned* p, unsigned v) { return __hip_atomic_fetch_add(p, v, __ATOMIC_RELAXED, __HIP_MEMORY_SCOPE_AGENT); }
__device__ __forceinline__ unsigned xb_xcc_id() { return (unsigned)__builtin_amdgcn_s_getreg((3 << 11) | 20) & 0xFu; }
#define XB_SPIN(cond, bar) do { unsigned _sp = 0; while (cond) { __builtin_amdgcn_s_sleep(1); \
    if ((++_sp & 255u) == 0u) { if (xb_ld(&(bar)[XB_TMO])) break; if (_sp > XB_SPIN_CAP) { atomicAdd(&(bar)[XB_TMO], 1u); break; } } } } while (0)
__device__ __forceinline__ void xcd_barrier_complete(unsigned* bar, unsigned x, unsigned& nloc, unsigned& nx) {
    const unsigned G = gridDim.x * gridDim.y * gridDim.z;
    unsigned sum, cnt, mine, sp = 0u;
    for (;;) {
        sum = 0u; cnt = 0u; mine = 0u;
#pragma unroll
        for (unsigned j = 0; j < 16; ++j) { const unsigned c = xb_ld(&bar[XB_XCNT(j)]); sum += c; cnt += (c > 0u) ? 1u : 0u; mine = (j == x) ? c : mine; }
        if (sum == G) break;
        __builtin_amdgcn_s_sleep(1);
        if ((++sp & 255u) == 0u) { if (xb_ld(&bar[XB_TMO])) break; if (sp > XB_SPIN_CAP) { atomicAdd(&bar[XB_TMO], 1u); break; } }
    }
    nloc = mine > 0u ? mine : 1u; nx = cnt > 0u ? cnt : 1u;
}
__device__ __forceinline__ void xcd_barrier(unsigned* bar, volatile LAS unsigned* st) {
    asm volatile("s_waitcnt vmcnt(0)" ::: "memory");
    __syncthreads();
    if (threadIdx.x == 0) {
        const unsigned x = xb_xcc_id();
        __builtin_amdgcn_s_waitcnt(0);
        unsigned nloc = st[0], nx = st[1];
        if (nloc == 0u) { xcd_barrier_complete(bar, x, nloc, nx); st[0] = nloc; st[1] = nx; }
        const unsigned old = xb_add(&bar[XB_XSUB(x)], 1u);
        const unsigned gen = old / nloc;
        if (old + 1u == (gen + 1u) * nloc) {
            __builtin_amdgcn_fence(__ATOMIC_RELEASE, "agent");
            asm volatile("s_waitcnt vmcnt(0)" ::: "memory");
            const unsigned og = xb_add(&bar[XB_TOP], 1u);
            const unsigned tg = og / nx;
            if (og + 1u == (tg + 1u) * nx) xb_add(&bar[XB_TOPGEN], 1u);
            else XB_SPIN(xb_ld(&bar[XB_TOPGEN]) == tg, bar);
            __builtin_amdgcn_fence(__ATOMIC_ACQUIRE, "agent");
            xb_add(&bar[XB_XGEN(x)], 1u);
            asm volatile("s_waitcnt vmcnt(0)" ::: "memory");
        } else {
            XB_SPIN(xb_ld(&bar[XB_XGEN(x)]) == gen, bar);
            __builtin_amdgcn_fence(__ATOMIC_ACQUIRE, "agent");
            asm volatile("s_waitcnt vmcnt(0)" ::: "memory");
        }
    }
    __syncthreads();
}
constexpr int LDS_MISC = LDS_BYTES - 64;

struct Args { const float* in[27]; float* out; unsigned char* ws; int ph_lo, ph_hi; };
static_assert(sizeof(Args) == 27 * 8 + 8 + 8 + 8, "no padding");
enum { I_XP = 0, I_XS, I_LNIG, I_LNIB, I_WIN, I_BIN, I_CRW, I_CRB, I_RWA, I_RBA, I_RWX, I_RBX, I_LAM, I_WG2, I_BG, I_NW, I_WPA, I_WPB, I_WOUT, I_LMG, I_LMB, I_WUP, I_CFW, I_CFB, I_WDN, I_LFG, I_LFB };

__device__ __forceinline__ void transpose_item(const float* W, int K, int N, bf16_t* WT, int k0, int n0, int drow, LAS float* scr, int lane) {
#pragma unroll 8
    for (int i = 0; i < 32; ++i) { const int kk = 2 * i + (lane >> 5); scr[kk * 33 + (lane & 31)] = W[(size_t)(k0 + kk) * N + n0 + (lane & 31)]; }
    asm volatile("s_waitcnt lgkmcnt(0)" ::: "memory");
    const int c = lane & 7;
#pragma unroll
    for (int j = 0; j < 4; ++j) { const int n = (lane >> 3) + 8 * j; const LAS float* s = scr + (8 * c) * 33 + n;
        u32x4 o; o.x = cvt_pk_bf16(s[0 * 33], s[1 * 33]); o.y = cvt_pk_bf16(s[2 * 33], s[3 * 33]); o.z = cvt_pk_bf16(s[4 * 33], s[5 * 33]); o.w = cvt_pk_bf16(s[6 * 33], s[7 * 33]);
        *(u32x4*)(WT + (size_t)(drow + n) * K + k0 + 8 * c) = o; }
    asm volatile("s_waitcnt lgkmcnt(0)" ::: "memory");
}
__device__ __forceinline__ int win_colmap(int n) { return n < 5120 ? n : (n < 5152 ? n + 4096 : n - 32); }

__device__ __forceinline__ void phase_convert(const Args& a, LAS unsigned char* lds, int G, int b, int tid) {
    const int wave = tid >> 6, lane = tid & 63;
    LAS float* scr = (LAS float*)(lds + wave * 16384);
    const int gw = b * 8 + wave, NGW = G * 8;
    constexpr int I_IN = 32 * 289, I_UP = 32 * 384, I_DN = 96 * 64, I_OUT = 32 * 64, I_PA = 16 * 64, I_L = I_IN + I_UP + I_DN + I_OUT + 2 * I_PA;
    for (int it = gw; it < DEPTH * I_L; it += NGW) {
        const int l = it / I_L; int r = it % I_L;
        unsigned char* lw = a.ws + (size_t)l * LW_SIZE;
        if (r < I_IN) { const int kb = r / 289, nb = r % 289; transpose_item(a.in[I_WIN] + (size_t)l * D * LDZ, D, LDZ, (bf16_t*)(lw + LW_WIN), kb * 64, nb * 32, win_colmap(nb * 32), scr, lane); continue; } r -= I_IN;
        if (r < I_UP) { const int kb = r / 384, nb = r % 384; transpose_item(a.in[I_WUP] + (size_t)l * D * 2 * DFF, D, 2 * DFF, (bf16_t*)(lw + LW_WUP), kb * 64, nb * 32, nb * 32, scr, lane); continue; } r -= I_UP;
        if (r < I_DN) { const int kb = r / 64, nb = r % 64; transpose_item(a.in[I_WDN] + (size_t)l * DFF * D, DFF, D, (bf16_t*)(lw + LW_WDN), kb * 64, nb * 32, nb * 32, scr, lane); continue; } r -= I_DN;
        if (r < I_OUT) { const int kb = r / 64, nb = r % 64; transpose_item(a.in[I_WOUT] + (size_t)l * D * D, D, D, (bf16_t*)(lw + LW_WOUT), kb * 64, nb * 32, nb * 32, scr, lane); continue; } r -= I_OUT;
        if (r < I_PA) { const int kb = r / 64, nb = r % 64; transpose_item(a.in[I_WPA] + (size_t)l * DRNN * D, DRNN, D, (bf16_t*)(lw + LW_WPA), kb * 64, nb * 32, nb * 32, scr, lane); continue; } r -= I_PA;
        { const int kb = r / 64, nb = r % 64; transpose_item(a.in[I_WPB] + (size_t)l * DRNN * D, DRNN, D, (bf16_t*)(lw + LW_WPB), kb * 64, nb * 32, nb * 32, scr, lane); }
    }
    const int gt = b * 512 + tid, NT = G * 512;
    for (int i = gt; i < DEPTH * 224 * 256; i += NT) { const int l = i / (224 * 256), r = i % (224 * 256);
        *(u32x4*)(a.ws + (size_t)l * LW_SIZE + LW_WIN + (size_t)LDZ * D * 2 + (size_t)r * 16) = (u32x4){0u, 0u, 0u, 0u}; }
    for (int i = gt; i < DEPTH * NZ; i += NT) { const int l = i / NZ, n = i % NZ; float* bp = (float*)(a.ws + (size_t)l * LW_SIZE + LW_BIAS);
        if (n >= LDZ) bp[n] = 0.f; else bp[win_colmap(n)] = a.in[I_BIN][(size_t)l * LDZ + n]; }
    for (int i = gt; i < DEPTH * 2 * 2 * 16 * 4096; i += NT) {
        const int ii = i & 63, j = (i >> 6) & 63, n = (i >> 12) & 15, dir = (i >> 16) & 1, which = (i >> 17) & 1, l = i >> 18;
        const float* src = which ? a.in[I_RWX] : a.in[I_RWA];
        const float v = src[((((size_t)l * 2 + dir) * 16 + n) * 64 + ii) * 64 + j];
        ((bf16_t*)(a.ws + (size_t)l * LW_SIZE + LW_RGW))[i & 262143] = f2bf(v);
    }
}

__device__ __forceinline__ void ln_row(const float* src, float* dstf, bf16_t* dstb, const float* gam, const float* bet, int lane, float* stat = nullptr) {
    const f32x4* s4 = (const f32x4*)src + lane;
    f32x4 v[8]; float s = 0.f;
#pragma unroll
    for (int j = 0; j < 8; ++j) { v[j] = s4[64 * j]; s += (v[j].x + v[j].y) + (v[j].z + v[j].w); }
    const float mean = wave_sum(s) * (1.f / D); float s2 = 0.f;
#pragma unroll
    for (int j = 0; j < 8; ++j) { v[j] = v[j] - mean; s2 += (v[j].x * v[j].x + v[j].y * v[j].y) + (v[j].z * v[j].z + v[j].w * v[j].w); }
    const float rstd = 1.f / sqrtf(wave_sum(s2) * (1.f / D) + EPS);
    if (stat && lane == 0) { stat[0] = mean; stat[1] = rstd; }
#pragma unroll
    for (int j = 0; j < 8; ++j) {
        const f32x4 gg = ((const f32x4*)gam)[lane + 64 * j], bb = ((const f32x4*)bet)[lane + 64 * j];
        const f32x4 o = v[j] * rstd * gg + bb;
        if (dstf) ((f32x4*)dstf)[lane + 64 * j] = o;
        if (dstb) { u32x2 w; w.x = cvt_pk_bf16(o.x, o.y); w.y = cvt_pk_bf16(o.z, o.w); ((u32x2*)dstb)[lane + 64 * j] = w; }
    }
}

template <int NR>
__device__ __forceinline__ void ln_rows(const float* src, float* dstf, bf16_t* dstb, float* stat, size_t rstride, const float* gam, const float* bet, int lane) {
    f32x4 v[NR][8]; float mean[NR], rstd[NR];
#pragma unroll
    for (int r = 0; r < NR; ++r)
#pragma unroll
        for (int j = 0; j < 8; ++j) v[r][j] = __builtin_nontemporal_load((const f32x4*)(src + r * rstride * D) + lane + 64 * j);
#pragma unroll
    for (int r = 0; r < NR; ++r) {
        float s = 0.f;
#pragma unroll
        for (int j = 0; j < 8; ++j) s += (v[r][j].x + v[r][j].y) + (v[r][j].z + v[r][j].w);
        mean[r] = wave_sum(s) * (1.f / D); float s2 = 0.f;
#pragma unroll
        for (int j = 0; j < 8; ++j) { v[r][j] = v[r][j] - mean[r]; s2 += (v[r][j].x * v[r][j].x + v[r][j].y * v[r][j].y) + (v[r][j].z * v[r][j].z + v[r][j].w * v[r][j].w); }
        rstd[r] = 1.f / sqrtf(wave_sum(s2) * (1.f / D) + EPS);
        if (stat && lane == 0) { stat[2 * r * rstride] = mean[r]; stat[2 * r * rstride + 1] = rstd[r]; }
    }
#pragma unroll
    for (int j = 0; j < 8; ++j) {
        const f32x4 gg = ((const f32x4*)gam)[lane + 64 * j], bb = ((const f32x4*)bet)[lane + 64 * j];
#pragma unroll
        for (int r = 0; r < NR; ++r) {
            const f32x4 o = v[r][j] * rstd[r] * gg + bb;
            if (dstf) ((f32x4*)(dstf + r * rstride * D))[lane + 64 * j] = o;
            if (dstb) { u32x2 p; p.x = cvt_pk_bf16(o.x, o.y); p.y = cvt_pk_bf16(o.z, o.w); ((u32x2*)(dstb + r * rstride * D))[lane + 64 * j] = p; }
        }
    }
}

constexpr int RG_XF = 0, RG_XB = 32768, RG_HF = 51200, RG_HB = 83968;
struct RgCtx { const bf16_t* Z; const float* cw; const float* cb; const bf16_t* rgw; const float* ba; const float* bx; const float* lam; float* carry; bf16_t* HA; int SL; };
template <int MODE, int DIR>
__device__ __forceinline__ void rg_wave(LAS unsigned char* lds, const RgCtx& c, int tile, int n, int ct, int lane) {
    const int fr = lane & 15, fq = lane >> 4, cl = 16 * ct + fr, ch = n * 64 + cl;
    bf16x8 Ba[2], Bx[2];
#pragma unroll
    for (int ks = 0; ks < 2; ++ks) {
        Ba[ks] = *(const bf16x8*)(c.rgw + ((((size_t)0 * 2 + DIR) * 16 + n) * 64 + cl) * 64 + 32 * ks + 8 * fq);
        Bx[ks] = *(const bf16x8*)(c.rgw + ((((size_t)1 * 2 + DIR) * 16 + n) * 64 + cl) * 64 + 32 * ks + 8 * fq);
    }
    const float ba = c.ba[DIR * DRNN + ch], bx = c.bx[DIR * DRNN + ch], lam = c.lam[DIR * DRNN + ch];
    const float c8sp = -8.f * log1pf(__expf(-lam));
    float* cA = c.carry + ((size_t)(0 * 2 + DIR) * 128) * DRNN; float* cH = c.carry + ((size_t)(1 * 2 + DIR) * 128) * DRNN;
    float Hc = 0.f, Ac = 1.f;
    if (MODE == 1) {
        const int tps = c.SL / 128, s0 = (tile / tps) * tps;
        const int first = DIR ? s0 + tps - 1 : s0, cnt = DIR ? (s0 + tps - 1 - tile) : (tile - s0);
        for (int k0 = 0; k0 < cnt; k0 += 8) {
            float a8[8], h8[8];
#pragma unroll
            for (int k = 0; k < 8; ++k) { const bool ok = (k0 + k) < cnt; const int pp = DIR ? first - (k0 + k) : first + (k0 + k);
                a8[k] = ok ? cA[(size_t)pp * DRNN + ch] : 1.f; h8[k] = ok ? cH[(size_t)pp * DRNN + ch] : 0.f; }
#pragma unroll
            for (int k = 0; k < 8; ++k) Hc = a8[k] * Hc + h8[k];
        }
    }
    const LAS float* XF = (const LAS float*)(lds + RG_XF);
    LAS float* HO = (LAS float*)(lds + (DIR ? RG_HB : RG_HF));
#pragma unroll 4
    for (int rti = 0; rti < 8; ++rti) {
        const int rt = DIR ? 7 - rti : rti;
        const bf16x8 A0 = *(const LAS bf16x8*)(lds + RG_XB + (16 * rt + fr) * 144 + 16 * fq);
        const bf16x8 A1 = *(const LAS bf16x8*)(lds + RG_XB + (16 * rt + fr) * 144 + 64 + 16 * fq);
        f32x4 racc = {0.f, 0.f, 0.f, 0.f}, iacc = {0.f, 0.f, 0.f, 0.f};
        racc = __builtin_amdgcn_mfma_f32_16x16x32_bf16(A0, Ba[0], racc, 0, 0, 0); racc = __builtin_amdgcn_mfma_f32_16x16x32_bf16(A1, Ba[1], racc, 0, 0, 0);
        iacc = __builtin_amdgcn_mfma_f32_16x16x32_bf16(A0, Bx[0], iacc, 0, 0, 0); iacc = __builtin_amdgcn_mfma_f32_16x16x32_bf16(A1, Bx[1], iacc, 0, 0, 0);
        f32x4 av4, uu4;
        {
            const f32x4 c60 = {60.f, 60.f, 60.f, 60.f};
            const f32x4 ta = __builtin_elementwise_min((racc + ba) * (-1.4426950408889634f), c60), tb = __builtin_elementwise_min((iacc + bx) * (-1.4426950408889634f), c60);
            f32x4 ea, eb;
#pragma unroll
            for (int j = 0; j < 4; ++j) { ea[j] = __builtin_amdgcn_exp2f(ta[j]); eb[j] = __builtin_amdgcn_exp2f(tb[j]); }
            const f32x4 da = ea + 1.f, db = eb + 1.f, dd = da * db;
            f32x4 R;
#pragma unroll
            for (int j = 0; j < 4; ++j) R[j] = __builtin_amdgcn_rcpf(dd[j]);
            const f32x4 r4 = db * R, ig4 = da * R;
            const f32x4 la2 = r4 * (c8sp * 1.4426950408889634f);
#pragma unroll
            for (int j = 0; j < 4; ++j) av4[j] = __builtin_amdgcn_exp2f(la2[j]);
            f32x4 om = 1.f - av4 * av4, xv4;
#pragma unroll
            for (int j = 0; j < 4; ++j) { om[j] = __builtin_amdgcn_sqrtf(fmaxf(om[j], 0.f)); xv4[j] = XF[(16 * rt + 4 * fq + j) * 64 + cl]; }
            uu4 = om * ig4 * xv4;
        }
        float hl[4], al[4]; float hp = 0.f, ap = 1.f;
#pragma unroll
        for (int jj = 0; jj < 4; ++jj) {
            const int j = DIR ? 3 - jj : jj;
            hp = av4[j] * hp + uu4[j]; ap = ap * av4[j]; hl[j] = hp; al[j] = ap;
        }
        float Hrun = Hc, Hin = 0.f, Aall = 1.f;
#pragma unroll
        for (int qq = 0; qq < 4; ++qq) {
            const int q = DIR ? 3 - qq : qq;
            const float Aq = __shfl(ap, fr + 16 * q), Hq = __shfl(hp, fr + 16 * q);
            if (q == fq) Hin = Hrun;
            Hrun = Aq * Hrun + Hq; Aall *= Aq;
        }
        Hc = Hrun; Ac *= Aall;
        if (MODE == 1) {
#pragma unroll
            for (int j = 0; j < 4; ++j) HO[(16 * rt + 4 * fq + j) * 64 + cl] = hl[j] + al[j] * Hin;
        }
    }
    if (MODE == 0 && fq == 0) { cA[(size_t)tile * DRNN + ch] = Ac; cH[(size_t)tile * DRNN + ch] = Hc; }
}

template <int MODE>
__device__ __forceinline__ void rg_tile(LAS unsigned char* lds, const RgCtx& c, int tile, int n, int tid) {
    const int wave = __builtin_amdgcn_readfirstlane(tid >> 6), lane = tid & 63;
    const int t0 = tile * 128;
    {
        const int c8 = tid & 7, tr = tid >> 3, ch0 = n * 64 + c8 * 8;
        f32x4 w[4][2], bb[2];
#pragma unroll
        for (int j = 0; j < 4; ++j) { w[j][0] = *(const f32x4*)(c.cw + j * DRNN + ch0); w[j][1] = *(const f32x4*)(c.cw + j * DRNN + ch0 + 4); }
        bb[0] = *(const f32x4*)(c.cb + ch0); bb[1] = *(const f32x4*)(c.cb + ch0 + 4);
#pragma unroll
        for (int h = 0; h < 2; ++h) {
            const int rr = tr + 64 * h, t = t0 + rr, pos = t & (c.SL - 1);
            float x[8] = {bb[0][0], bb[0][1], bb[0][2], bb[0][3], bb[1][0], bb[1][1], bb[1][2], bb[1][3]};
#pragma unroll
            for (int j = 0; j < 4; ++j) {
                const int pp = pos + j - 2;
                if (pp >= 0 && pp < c.SL) {
                    float zf[8]; unpack8(*(const u32x4*)(c.Z + (size_t)(t + j - 2) * LDZ + ZC_RX + ch0), zf);
#pragma unroll
                    for (int e = 0; e < 8; ++e) x[e] += w[j][e >> 2][e & 3] * zf[e];
                }
            }
            *(LAS f32x4*)(lds + RG_XF + (rr * 64 + c8 * 8) * 4) = (f32x4){x[0], x[1], x[2], x[3]};
            *(LAS f32x4*)(lds + RG_XF + (rr * 64 + c8 * 8 + 4) * 4) = (f32x4){x[4], x[5], x[6], x[7]};
            *(LAS u32x4*)(lds + RG_XB + rr * 144 + c8 * 16) = pack8(x);
        }
    }
    u32x4 gpre[2] = {{0u, 0u, 0u, 0u}, {0u, 0u, 0u, 0u}};
    if (MODE == 1) { const int tok = tid >> 2, cs = (tid & 3) * 16;
#pragma unroll
        for (int h = 0; h < 2; ++h) gpre[h] = *(const u32x4*)(c.Z + (size_t)(t0 + tok) * LDZ + ZC_RG + n * 64 + cs + 8 * h); }
    WG_BARRIER();
    if (wave < 4) rg_wave<MODE, 0>(lds, c, tile, n, wave & 3, lane); else rg_wave<MODE, 1>(lds, c, tile, n, wave & 3, lane);
    WG_BARRIER();
    if (MODE == 1) {
        const int tok = tid >> 2, cs = (tid & 3) * 16;
        const LAS float* hf = (const LAS float*)(lds + RG_HF) + tok * 64 + cs; const LAS float* hb = (const LAS float*)(lds + RG_HB) + tok * 64 + cs;
#pragma unroll
        for (int h = 0; h < 2; ++h) {
            float gt[8]; unpack8(gpre[h], gt);
#pragma unroll
            for (int e = 0; e < 8; ++e) gt[e] = gelu_tanh(gt[e]);
            const f32x4 f0 = *(const LAS f32x4*)(hf + 8 * h), f1 = *(const LAS f32x4*)(hf + 8 * h + 4), b0 = *(const LAS f32x4*)(hb + 8 * h), b1 = *(const LAS f32x4*)(hb + 8 * h + 4);
            float o[8] = {gt[0] * (f0[0] + b0[0]), gt[1] * (f0[1] + b0[1]), gt[2] * (f0[2] + b0[2]), gt[3] * (f0[3] + b0[3]),
                          gt[4] * (f1[0] + b1[0]), gt[5] * (f1[1] + b1[1]), gt[6] * (f1[2] + b1[2]), gt[7] * (f1[3] + b1[3])};
            *(u32x4*)(c.HA + (size_t)(t0 + tok) * DRNN + n * 64 + cs + 8 * h) = pack8(o);
        }
    }
}

template <int MODE>
__device__ __forceinline__ void rg_phase(LAS unsigned char* lds, const RgCtx& c, int u0, int ustride, int tid) {
    constexpr int NU = 128 * 16;
    if (u0 >= NU) return;
    const int wave = __builtin_amdgcn_readfirstlane(tid >> 6), lane = tid & 63;
    const int c8 = tid & 7, tr = tid >> 3;
    u32x4 zr[2][4];
#define RG_LOAD(u_) do { const int tile_ = (u_) >> 4, ch0_ = ((u_) & 15) * 64 + c8 * 8; \
        _Pragma("unroll") for (int hh = 0; hh < 2; ++hh) { const int t_ = tile_ * 128 + tr + 64 * hh, pos_ = t_ & (c.SL - 1); \
            _Pragma("unroll") for (int j = 0; j < 4; ++j) { const int pp_ = pos_ + j - 2; const int tt_ = (pp_ >= 0 && pp_ < c.SL) ? t_ + j - 2 : t_;     \
                zr[hh][j] = *(const u32x4*)(c.Z + (size_t)tt_ * LDZ + ZC_RX + ch0_); } } } while (0)
    RG_LOAD(u0);
    const bool nconst = (ustride & 15) == 0;
    f32x4 w[4][2], bb[2];
#define RG_WLOAD(n_) do { const int ch0_ = (n_) * 64 + c8 * 8; \
        _Pragma("unroll") for (int j = 0; j < 4; ++j) { w[j][0] = *(const f32x4*)(c.cw + j * DRNN + ch0_); w[j][1] = *(const f32x4*)(c.cw + j * DRNN + ch0_ + 4); } \
        bb[0] = *(const f32x4*)(c.cb + ch0_); bb[1] = *(const f32x4*)(c.cb + ch0_ + 4); } while (0)
    RG_WLOAD(u0 & 15);
#pragma unroll 1
    for (int u = u0; u < NU; u += ustride) {
        const int tile = u >> 4, n = u & 15, t0 = tile * 128;
        {
            if (!nconst) RG_WLOAD(n);
#pragma unroll
            for (int h = 0; h < 2; ++h) {
                const int rr = tr + 64 * h, t = t0 + rr, pos = t & (c.SL - 1);
                float x[8] = {bb[0][0], bb[0][1], bb[0][2], bb[0][3], bb[1][0], bb[1][1], bb[1][2], bb[1][3]};
#pragma unroll
                for (int j = 0; j < 4; ++j) {
                    const int pp = pos + j - 2;
                    float zf[8]; unpack8(zr[h][j], zf);
                    const float msk = (pp >= 0 && pp < c.SL) ? 1.f : 0.f;
#pragma unroll
                    for (int e = 0; e < 8; ++e) x[e] += w[j][e >> 2][e & 3] * (zf[e] * msk);
                }
                *(LAS f32x4*)(lds + RG_XF + (rr * 64 + c8 * 8) * 4) = (f32x4){x[0], x[1], x[2], x[3]};
                *(LAS f32x4*)(lds + RG_XF + (rr * 64 + c8 * 8 + 4) * 4) = (f32x4){x[4], x[5], x[6], x[7]};
                *(LAS u32x4*)(lds + RG_XB + rr * 144 + c8 * 16) = pack8(x);
            }
        }
        u32x4 gpre[2] = {{0u, 0u, 0u, 0u}, {0u, 0u, 0u, 0u}};
        if (MODE == 1) { const int tok = tid >> 2, cs = (tid & 3) * 16;
#pragma unroll
            for (int h = 0; h < 2; ++h) gpre[h] = *(const u32x4*)(c.Z + (size_t)(t0 + tok) * LDZ + ZC_RG + n * 64 + cs + 8 * h); }
        { const int un = (u + ustride < NU) ? u + ustride : u; RG_LOAD(un); }
        WG_BARRIER();
        if (wave < 4) rg_wave<MODE, 0>(lds, c, tile, n, wave & 3, lane); else rg_wave<MODE, 1>(lds, c, tile, n, wave & 3, lane);
        WG_BARRIER();
        if (MODE == 1) {
            const int tok = tid >> 2, cs = (tid & 3) * 16;
            const LAS float* hf = (const LAS float*)(lds + RG_HF) + tok * 64 + cs; const LAS float* hb = (const LAS float*)(lds + RG_HB) + tok * 64 + cs;
#pragma unroll
            for (int h = 0; h < 2; ++h) {
                float gt[8]; unpack8(gpre[h], gt);
#pragma unroll
                for (int e = 0; e < 8; ++e) gt[e] = gelu_tanh(gt[e]);
                const f32x4 f0 = *(const LAS f32x4*)(hf + 8 * h), f1 = *(const LAS f32x4*)(hf + 8 * h + 4), b0 = *(const LAS f32x4*)(hb + 8 * h), b1 = *(const LAS f32x4*)(hb + 8 * h + 4);
                float o[8] = {gt[0] * (f0[0] + b0[0]), gt[1] * (f0[1] + b0[1]), gt[2] * (f0[2] + b0[2]), gt[3] * (f0[3] + b0[3]),
                              gt[4] * (f1[0] + b1[0]), gt[5] * (f1[1] + b1[1]), gt[6] * (f1[2] + b1[2]), gt[7] * (f1[3] + b1[3])};
                *(u32x4*)(c.HA + (size_t)(t0 + tok) * DRNN + n * 64 + cs + 8 * h) = pack8(o);
            }
        }
    }
#undef RG_LOAD
#undef RG_WLOAD
}

constexpr int GL_QD = 0, GL_KD = 17408, GL_KET = 34816, GL_VT = 53248, GL_ATT = 62464, GL_ST = 71680, GL_GCS = 89088  , GL_GS = 122880, GL_DEC = 123392, GL_ZGS = 123904;
constexpr int GCS_LD = 132;
struct GlaCtx { const bf16_t* Z; const float* wg2; const float* bg; bf16_t* OF; bf16_t* OK; bf16_t* QDG; bf16_t* KDG; bf16_t* KETG; float* DECG; bf16_t* ATTG; int SL; };
constexpr int NCKG = TG / 64;
template <int DIR>
__device__ __forceinline__ void gla_pre(LAS unsigned char* lds, const GlaCtx& c, int ck, int h, int tid) {
    const int wave = __builtin_amdgcn_readfirstlane(tid >> 6), lane = tid & 63, fr = lane & 15, fq = lane >> 4;
    const int ct_ = tid >> 3, sub = tid & 7;
    bf16x8 wgB;
    {
        float wv[8];
#pragma unroll
        for (int i = 0; i < 8; ++i) wv[i] = (fq < 2) ? c.wg2[((size_t)DIR * 16 + 8 * fq + i) * 512 + h * 128 + 16 * wave + fr] : 0.f;
        const u32x4 wp = pack8(wv); wgB = __builtin_bit_cast(bf16x8, wp);
    }
    const float bgd = c.bg[DIR * 512 + h * 128 + 16 * wave + fr];
    const size_t row0 = (size_t)ck * 64;
    const bf16_t* zr = c.Z + (row0 + ct_) * LDZ;
    u32x4 qraw[2], kraw[2];
    qraw[0] = *(const u32x4*)(zr + ZC_Q + h * 128 + sub * 16); qraw[1] = *(const u32x4*)(zr + ZC_Q + h * 128 + sub * 16 + 8);
    kraw[0] = *(const u32x4*)(zr + ZC_K + h * 128 + sub * 16); kraw[1] = *(const u32x4*)(zr + ZC_K + h * 128 + sub * 16 + 8);
    if (tid < 128) *(LAS u32x4*)(lds + GL_ZGS + (tid >> 1) * 32 + (tid & 1) * 16) = *(const u32x4*)(c.Z + (row0 + (tid >> 1)) * LDZ + ZC_GF + DIR * 16 + (tid & 1) * 8);
    WG_BARRIER();
    {
        LAS float* gcs = (LAS float*)(lds + GL_GCS);
        float carry = 0.f;
#pragma unroll
        for (int tti = 0; tti < 4; ++tti) {
            const int tt = DIR ? 3 - tti : tti;
            bf16x8 Az = {0, 0, 0, 0, 0, 0, 0, 0};
            if (fq < 2) Az = *(const LAS bf16x8*)(lds + GL_ZGS + (16 * tt + fr) * 32 + fq * 16);
            f32x4 lg4 = {0.f, 0.f, 0.f, 0.f};
            lg4 = __builtin_amdgcn_mfma_f32_16x16x32_bf16(Az, wgB, lg4, 0, 0, 0);
            float gv[4];
#pragma unroll
            for (int j = 0; j < 4; ++j) {
                const float lg = lg4[j] + bgd;
                float ls = -__logf(1.f + __expf(-fmaxf(lg, -60.f)));
                if (lg < -60.f) ls = lg;
                gv[j] = ls * 0.0625f;
            }
            float pj[4];
            if (DIR == 0) { pj[0] = gv[0]; pj[1] = pj[0] + gv[1]; pj[2] = pj[1] + gv[2]; pj[3] = pj[2] + gv[3]; }
            else { pj[3] = gv[3]; pj[2] = pj[3] + gv[2]; pj[1] = pj[2] + gv[1]; pj[0] = pj[1] + gv[0]; }
            const float T = DIR ? pj[0] : pj[3];
            const float T0 = __shfl(T, fr), T1 = __shfl(T, fr + 16), T2 = __shfl(T, fr + 32), T3 = __shfl(T, fr + 48);
            float excl = 0.f;
            if (DIR == 0) { if (fq > 0) excl += T0; if (fq > 1) excl += T1; if (fq > 2) excl += T2; }
            else { if (fq < 3) excl += T3; if (fq < 2) excl += T2; if (fq < 1) excl += T1; }
            const float base = carry + excl;
#pragma unroll
            for (int j = 0; j < 4; ++j) gcs[(16 * tt + 4 * fq + j) * GCS_LD + 16 * wave + fr] = base + pj[j];
            carry += (T0 + T1) + (T2 + T3);
        }
        if (fq == 0) ((LAS float*)(lds + GL_GS))[16 * wave + fr] = carry;
    }
    WG_BARRIER();
    {
        const LAS float* gs = (const LAS float*)(lds + GL_GS) + sub * 16;
        const LAS float* gcs = (const LAS float*)(lds + GL_GCS) + ct_ * GCS_LD + sub * 16;
        float qf[16], kf[16];
        { float t8[8]; unpack8(qraw[0], t8);
#pragma unroll
          for (int e = 0; e < 8; ++e) qf[e] = t8[e];
          unpack8(qraw[1], t8);
#pragma unroll
          for (int e = 0; e < 8; ++e) qf[8 + e] = t8[e];
          unpack8(kraw[0], t8);
#pragma unroll
          for (int e = 0; e < 8; ++e) kf[e] = t8[e];
          unpack8(kraw[1], t8);
#pragma unroll
          for (int e = 0; e < 8; ++e) kf[8 + e] = t8[e]; }
        float qd[16], kd[16];
        LAS bf16_t* ket = (LAS bf16_t*)(lds + GL_KET);
        float* decg = c.DECG + (((size_t)DIR * NCKG + ck) * 4 + h) * 128;
#pragma unroll
        for (int e4 = 0; e4 < 4; ++e4) {
            const f32x4 tt4 = *(const LAS f32x4*)(gs + 4 * e4);
            const f32x4 gl = *(const LAS f32x4*)(gcs + 4 * e4);
            if (ct_ == 0) *(f32x4*)(decg + sub * 16 + 4 * e4) = (f32x4){__expf(tt4[0]), __expf(tt4[1]), __expf(tt4[2]), __expf(tt4[3])};
#pragma unroll
            for (int e1 = 0; e1 < 4; ++e1) {
                const int e = 4 * e4 + e1;
                const float tot = tt4[e1], gc = gl[e1];
                const float eq = __expf(gc), ek = __expf(-gc), ee = __expf(tot - gc);
                qd[e] = qf[e] * eq; kd[e] = kf[e] * ek;
                ket[(sub * 16 + e) * 72 + (ct_ ^ (8 * sub))] = f2bf(kf[e] * ee);
            }
        }
        bf16_t* qg = c.QDG + ((size_t)DIR * TG + row0 + ct_) * 512 + h * 128 + sub * 16;
        bf16_t* kg = c.KDG + ((size_t)DIR * TG + row0 + ct_) * 512 + h * 128 + sub * 16;
        float t8[8];
#pragma unroll
        for (int hh = 0; hh < 2; ++hh) {
#pragma unroll
            for (int e = 0; e < 8; ++e) t8[e] = qd[8 * hh + e];
            { const u32x4 w = pack8(t8); *(u32x4*)(qg + 8 * hh) = w; *(LAS u32x4*)(lds + GL_QD + ct_ * 272 + sub * 32 + hh * 16) = w; }
#pragma unroll
            for (int e = 0; e < 8; ++e) t8[e] = kd[8 * hh + e];
            *(LAS u32x4*)(lds + GL_KD + ct_ * 272 + sub * 32 + hh * 16) = pack8(t8);
        }
    }
    WG_BARRIER();
    {
        const int d = tid >> 2, part = tid & 3;
        const u32x4 r0 = *(const LAS u32x4*)(lds + GL_KET + d * 144 + part * 32), r1 = *(const LAS u32x4*)(lds + GL_KET + d * 144 + part * 32 + 16);
        bf16_t* kt = c.KETG + ((((size_t)DIR * NCKG + ck) * 4 + h) * 128 + d) * 64 + part * 16;
        *(u32x4*)kt = r0; *(u32x4*)(kt + 8) = r1;
    }
    {
        const int ctile = wave >> 1;
        bf16x8 Aq[4];
#pragma unroll
        for (int ks = 0; ks < 4; ++ks) Aq[ks] = *(const LAS bf16x8*)(lds + GL_QD + (16 * ctile + fr) * 272 + ks * 64 + fq * 16);
#pragma unroll
        for (int s2 = 0; s2 < 2; ++s2) {
            const int st = 2 * (wave & 1) + s2;
            f32x4 acc = {0.f, 0.f, 0.f, 0.f};
#pragma unroll
            for (int ks = 0; ks < 4; ++ks) { const bf16x8 Bk = *(const LAS bf16x8*)(lds + GL_KD + (16 * st + fr) * 272 + ks * 64 + fq * 16);
                acc = __builtin_amdgcn_mfma_f32_16x16x32_bf16(Aq[ks], Bk, acc, 0, 0, 0); }
            LAS bf16_t* att = (LAS bf16_t*)(lds + GL_ATT);
#pragma unroll
            for (int j = 0; j < 4; ++j) { const int cc = 16 * ctile + 4 * fq + j, ss = 16 * st + fr;
                const bool keep = DIR ? (cc <= ss) : (cc >= ss);
                att[cc * 72 + ss] = f2bf(keep ? acc[j] : 0.f); }
        }
    }
    WG_BARRIER();
    {
        const int r = tid >> 3, part = tid & 7;
        *(u32x4*)(c.ATTG + ((((size_t)DIR * NCKG + ck) * 4 + h) * 64 + r) * 64 + part * 8) = *(const LAS u32x4*)(lds + GL_ATT + r * 144 + part * 16);
    }
    WG_BARRIER();
}

constexpr int SQ_QD = 0, SQ_KET = 17408, SQ_ATT = 35840, SQ_VT = 45056, SQ_ST = 54272, SQ_DEC = 71680, SQ_BUF = 72192;
static_assert(2 * SQ_BUF <= LDS_BYTES - 64, "GLA sequential LDS images");
template <int DIR>
__device__ __forceinline__ void gla_seq(LAS unsigned char* lds, const GlaCtx& c, int seq, int h, int sl, int tid) {
    const int wave = __builtin_amdgcn_readfirstlane(tid >> 6), lane = tid & 63, fr = lane & 15, fq = lane >> 4;
    const int NC = c.SL / 64;
    const int ct_ = tid >> 3, sub = tid & 7;
    bf16_t* Odst = DIR ? c.OK : c.OF;
    f32x4 S[4];
#pragma unroll
    for (int i = 0; i < 4; ++i) S[i] = (f32x4){0.f, 0.f, 0.f, 0.f};
    u32x4 qdr[2][2], ker[2][2], atr[2], vraw[2]; f32x4 decr[2];
#define GLA_ISSUE(chunk_, set_) do { \
        const size_t row_ = (size_t)seq * c.SL + (size_t)(chunk_) * 64; \
        const size_t ckh_ = (((size_t)DIR * NCKG + (row_ >> 6)) * 4 + h); \
        const bf16_t* qg_ = c.QDG + ((size_t)DIR * TG + row_ + ct_) * 512 + h * 128 + sub * 16; \
        qdr[set_][0] = *(const u32x4*)qg_; qdr[set_][1] = *(const u32x4*)(qg_ + 8); \
        const bf16_t* kt_ = c.KETG + (ckh_ * 128 + (tid >> 2)) * 64 + (tid & 3) * 16; \
        ker[set_][0] = *(const u32x4*)kt_; ker[set_][1] = *(const u32x4*)(kt_ + 8); \
        atr[set_] = *(const u32x4*)(c.ATTG + (ckh_ * 64 + ct_) * 64 + sub * 8); \
        vraw[set_] = *(const u32x4*)(c.Z + (row_ + ct_) * LDZ + ZC_V + h * 256 + sl * 64 + sub * 8); \
        decr[set_] = *(const f32x4*)(c.DECG + ckh_ * 128 + (tid & 31) * 4); } while (0)
#define GLA_STAGE(set_, img_) do { \
        LAS unsigned char* B_ = lds + (img_) * SQ_BUF; \
        *(LAS u32x4*)(B_ + SQ_QD + ct_ * 272 + sub * 32) = qdr[set_][0]; *(LAS u32x4*)(B_ + SQ_QD + ct_ * 272 + sub * 32 + 16) = qdr[set_][1]; \
        *(LAS u32x4*)(B_ + SQ_KET + (tid >> 2) * 144 + (tid & 3) * 32) = ker[set_][0]; *(LAS u32x4*)(B_ + SQ_KET + (tid >> 2) * 144 + (tid & 3) * 32 + 16) = ker[set_][1]; \
        *(LAS u32x4*)(B_ + SQ_ATT + ct_ * 144 + sub * 16) = atr[set_]; \
        if (tid < 32) *(LAS f32x4*)(B_ + SQ_DEC + tid * 16) = decr[set_]; \
        { LAS bf16_t* vt_ = (LAS bf16_t*)(B_ + SQ_VT); const unsigned vw_[4] = {vraw[set_].x, vraw[set_].y, vraw[set_].z, vraw[set_].w}; \
          _Pragma("unroll") for (int e = 0; e < 4; ++e) { vt_[(sub * 8 + 2 * e) * 72 + (ct_ ^ (8 * sub))] = (bf16_t)(vw_[e] & 0xffffu); vt_[(sub * 8 + 2 * e + 1) * 72 + (ct_ ^ (8 * sub))] = (bf16_t)(vw_[e] >> 16); } } \
        _Pragma("unroll") for (int dt = 0; dt < 4; ++dt) { u32x2 w_; w_.x = cvt_pk_bf16(S[dt][0], S[dt][1]); w_.y = cvt_pk_bf16(S[dt][2], S[dt][3]); \
            *(LAS u32x2*)(B_ + SQ_ST + (16 * dt + fr) * 272 + (16 * wave + 4 * fq) * 2) = w_; } } while (0)
    GLA_ISSUE(DIR ? NC - 1 : 0, 0);
    GLA_ISSUE(DIR ? NC - 2 : 1, 1);
    GLA_STAGE(0, 0);
    GLA_ISSUE(DIR ? NC - 3 : 2, 0);
    WG_BARRIER();
#pragma unroll 1
    for (int ci2 = 0; ci2 < NC; ci2 += 2) {
#pragma unroll
      for (int ph = 0; ph < 2; ++ph) {
        const int ci = ci2 + ph;
        const int chunk = DIR ? NC - 1 - ci : ci;
        LAS unsigned char* B = lds + ph * SQ_BUF;
        {
            const int ctile = wave >> 1;
            const size_t row0 = (size_t)seq * c.SL + (size_t)chunk * 64;
            bf16x8 Aa[2], Aq[4], Bv[4][2];
#pragma unroll
            for (int dt = 0; dt < 4; ++dt)
#pragma unroll
                for (int ks = 0; ks < 2; ++ks) Bv[dt][ks] = *(const LAS bf16x8*)(B + SQ_VT + (16 * dt + fr) * 144 + (((32 * ks + 8 * fq) ^ (8 * ((2 * dt + (fr >> 3)) & 7))) * 2));
#pragma unroll
            for (int ks = 0; ks < 2; ++ks) Aa[ks] = *(const LAS bf16x8*)(B + SQ_ATT + (16 * ctile + fr) * 144 + ks * 64 + fq * 16);
#pragma unroll
            for (int ks = 0; ks < 4; ++ks) Aq[ks] = *(const LAS bf16x8*)(B + SQ_QD + (16 * ctile + fr) * 272 + ks * 64 + fq * 16);
#define GLA_OTILE(dt_) do { \
                f32x4 acc = {0.f, 0.f, 0.f, 0.f}; \
                  \
                _Pragma("unroll") for (int ks = 0; ks < 2; ++ks) acc = __builtin_amdgcn_mfma_f32_16x16x32_bf16(Bv[dt_][ks], Aa[ks], acc, 0, 0, 0); \
                _Pragma("unroll") for (int ks = 0; ks < 4; ++ks) { const bf16x8 Bs = *(const LAS bf16x8*)(B + SQ_ST + (16 * (dt_) + fr) * 272 + ks * 64 + fq * 16); \
                    acc = __builtin_amdgcn_mfma_f32_16x16x32_bf16(Bs, Aq[ks], acc, 0, 0, 0); } \
                { u32x2 w_; w_.x = cvt_pk_bf16(acc[0], acc[1]); w_.y = cvt_pk_bf16(acc[2], acc[3]); \
                  *(u32x2*)(Odst + (row0 + 16 * ctile + fr) * DRNN + h * 256 + sl * 64 + 16 * (dt_) + 4 * fq) = w_; } } while (0)
            if (wave & 1) { GLA_OTILE(2); GLA_OTILE(3); } else { GLA_OTILE(0); GLA_OTILE(1); }
#undef GLA_OTILE
            const f32x4 dec = *(const LAS f32x4*)(B + SQ_DEC + (16 * wave + 4 * fq) * 4);
            bf16x8 Ak[2];
#pragma unroll
            for (int ks = 0; ks < 2; ++ks) Ak[ks] = *(const LAS bf16x8*)(B + SQ_KET + (16 * wave + fr) * 144 + (((32 * ks + 8 * fq) ^ (8 * wave)) * 2));
#pragma unroll
            for (int dt = 0; dt < 4; ++dt) {
                S[dt] = S[dt] * dec;
#pragma unroll
                for (int ks = 0; ks < 2; ++ks) S[dt] = __builtin_amdgcn_mfma_f32_16x16x32_bf16(Ak[ks], Bv[dt][ks], S[dt], 0, 0, 0);
            }
        }
        GLA_STAGE(ph ^ 1, ph ^ 1);
        { const int cn = DIR ? (NC - 4 - ci > 0 ? NC - 4 - ci : 0) : (ci + 3 < NC - 1 ? ci + 3 : NC - 1); GLA_ISSUE(cn, ph ^ 1); }
        WG_BARRIER();
      }
    }
#undef GLA_ISSUE
#undef GLA_STAGE
}

__device__ __forceinline__ void gla_finalize(const bf16_t* Z, const bf16_t* OF, const bf16_t* OK, const float* nw, bf16_t* OB, int G, int b, int tid) {
    const int l32 = tid & 31, pr = tid >> 5;
    const f32x4 w0 = *(const f32x4*)(nw + l32 * 8), w1 = *(const f32x4*)(nw + l32 * 8 + 4);
    constexpr int NIT = TG * 4 / 16, FB = 4;
    for (int it0 = b; it0 < NIT; it0 += FB * G) {
        u32x4 ra[FB], rb[FB], rg[FB];
#pragma unroll
        for (int k = 0; k < FB; ++k) { const int it = it0 + k * G; if (it < NIT) {
            const int pair = it * 16 + pr, t = pair >> 2, hd = pair & 3; const size_t o = (size_t)t * DRNN + hd * 256 + l32 * 8;
            ra[k] = *(const u32x4*)(OF + o); rb[k] = *(const u32x4*)(OK + o); rg[k] = *(const u32x4*)(Z + (size_t)t * LDZ + ZC_OG + hd * 256 + l32 * 8); } }
#pragma unroll
        for (int k = 0; k < FB; ++k) { const int it = it0 + k * G; if (it < NIT) {
            const int pair = it * 16 + pr, t = pair >> 2, hd = pair & 3; const size_t o = (size_t)t * DRNN + hd * 256 + l32 * 8;
            float a[8], bb[8], gq[8];
            unpack8(ra[k], a); unpack8(rb[k], bb); unpack8(rg[k], gq);
            float ss = 0.f;
#pragma unroll
            for (int e = 0; e < 8; ++e) { a[e] += bb[e]; ss += a[e] * a[e]; gq[e] = gq[e] * sigmoid_f(gq[e]); }
#pragma unroll
            for (int off = 1; off < 32; off <<= 1) ss += __shfl_xor(ss, off);
            const float rs = 1.f / sqrtf(ss * (1.f / 256.f) + EPS);
            float r[8] = {a[0] * rs * w0[0] * gq[0], a[1] * rs * w0[1] * gq[1], a[2] * rs * w0[2] * gq[2], a[3] * rs * w0[3] * gq[3],
                          a[4] * rs * w1[0] * gq[4], a[5] * rs * w1[1] * gq[5], a[6] * rs * w1[2] * gq[6], a[7] * rs * w1[3] * gq[7]};
            *(u32x4*)(OB + o) = pack8(r); } }
    }
}

__device__ __forceinline__ void ff_elem(const bf16_t* U, const float* cw, const float* cb, bf16_t* HDN, int SL, int G, int b, int tid) {
    const int NIT = (TG / 32) * (DFF / 8);
    for (int it = b * 512 + tid; it < NIT; it += G * 512) {
        const int rb = it / (DFF / 8), cgp = it % (DFF / 8), r0 = rb * 32, c0 = cgp * 8;
        float w0[8], w1[8], w2[8], bb[8];
#pragma unroll
        for (int e = 0; e < 8; ++e) { w0[e] = cw[c0 + e]; w1[e] = cw[DFF + c0 + e]; w2[e] = cw[2 * DFF + c0 + e]; bb[e] = cb[c0 + e]; }
        float pv[8], cv[8], nv[8];
        if ((r0 & (SL - 1)) == 0) {
#pragma unroll
            for (int e = 0; e < 8; ++e) pv[e] = 0.f;
        } else unpack8(*(const u32x4*)(U + (size_t)(r0 - 1) * (2 * DFF) + c0), pv);
        unpack8(*(const u32x4*)(U + (size_t)r0 * (2 * DFF) + c0), cv);
        u32x4 gq[2][8], vq[2][8];
#define FF_LOAD(sb_, set_) do { _Pragma("unroll") for (int k = 0; k < 8; ++k) { const int r_ = r0 + (sb_) * 8 + k; \
            gq[set_][k] = __builtin_nontemporal_load((const u32x4*)(U + (size_t)(r_ + 1) * (2 * DFF) + c0)); \
            vq[set_][k] = __builtin_nontemporal_load((const u32x4*)(U + (size_t)r_ * (2 * DFF) + DFF + c0)); } } while (0)
#define FF_DO(sb_, set_) do { _Pragma("unroll") for (int k = 0; k < 8; ++k) { const int r = r0 + (sb_) * 8 + k; \
            unpack8(gq[set_][k], nv); \
            if (((r + 1) & (SL - 1)) == 0) { _Pragma("unroll") for (int e = 0; e < 8; ++e) nv[e] = 0.f; } \
            float uv[8]; unpack8(vq[set_][k], uv); float o[8]; \
            _Pragma("unroll") for (int e = 0; e < 8; ++e) { const float pre = bb[e] + w0[e] * pv[e] + w1[e] * cv[e] + w2[e] * nv[e]; o[e] = gelu_tanh(pre) * uv[e]; pv[e] = cv[e]; cv[e] = nv[e]; } \
            *(u32x4*)(HDN + (size_t)r * DFF + c0) = pack8(o); } } while (0)
        FF_LOAD(0, 0);
        FF_LOAD(1, 1); FF_DO(0, 0);
        FF_LOAD(2, 0); FF_DO(1, 1);
        FF_LOAD(3, 1); FF_DO(2, 0);
        FF_DO(3, 1);
#undef FF_LOAD
#undef FF_DO
    }
}

typedef const __attribute__((address_space(4))) Args* KArgs;
#define AIN(i) ((const float*)ap->in[i])
__global__ void __launch_bounds__(512, 2) mega_fwd(Args a_byval) {
    extern __shared__ __attribute__((aligned(16))) unsigned char lds_raw[];
    LAS unsigned char* lds = (LAS unsigned char*)lds_raw;
    int p, hi;
    { KArgs ap0 = (KArgs)__builtin_amdgcn_kernarg_segment_ptr(); p = ap0->ph_lo; hi = ap0->ph_hi;
      if (threadIdx.x == 0) { ((volatile LAS unsigned*)(lds + LDS_MISC))[0] = 0u; ((volatile LAS unsigned*)(lds + LDS_MISC))[1] = 0u;
          if (hi - p > 1) (void)xb_add((unsigned*)(ap0->ws + WS_CTL) + XB_XCNT(xb_xcc_id()), 1u); }
      __syncthreads(); }
    for (; p < hi; ++p) {
        int nrep = 1;
        if (REPMASK) { const int rr = (p == 0) ? 10 : (((p - 1) % PH_PER_GROUP == 0) ? 11 : (((p - 1) % PH_PER_GROUP - 1) % PH_PER_LAYER)); if ((REPMASK >> rr) & 1) nrep = 2; }
        for (int rep = 0; rep < nrep; ++rep) {
        KArgs ap = (KArgs)__builtin_amdgcn_kernarg_segment_ptr();
        asm volatile("" : "+s"(ap) :: "memory");
        int tid = threadIdx.x, b = blockIdx.x, G = gridDim.x;
        asm volatile("" : "+v"(tid), "+s"(b), "+s"(G));
        const int wave = __builtin_amdgcn_readfirstlane(tid >> 6), lane = tid & 63;
        unsigned char* ws = ap->ws;
        if (p == 0) { {
            Args a;
            a.in[I_WIN] = AIN(I_WIN); a.in[I_WUP] = AIN(I_WUP); a.in[I_WDN] = AIN(I_WDN); a.in[I_WOUT] = AIN(I_WOUT); a.in[I_WPA] = AIN(I_WPA); a.in[I_WPB] = AIN(I_WPB);
            a.in[I_BIN] = AIN(I_BIN); a.in[I_RWA] = AIN(I_RWA); a.in[I_RWX] = AIN(I_RWX); a.ws = ws;
            phase_convert(a, lds, G, b, tid); }
        } else {
            const int q = p - 1, g = q / PH_PER_GROUP, r = q % PH_PER_GROUP;
            float* X = ap->out + (size_t)g * TG * D;
            const int SL = (g == 0) ? 8192 : 2048;
            bf16_t* XN = (bf16_t*)(ws + WS_XN);
            if (r == 0) { {
                const float* src = (g == 0) ? AIN(I_XP) : AIN(I_XS) + (size_t)(g - 1) * TG * D;
                const float* gam = AIN(I_LNIG); const float* bet = AIN(I_LNIB);
                for (int m = b * 8 + wave; m < TG / LNR; m += G * 8) ln_rows<LNR>(src + (size_t)m * D, X + (size_t)m * D, XN + (size_t)m * D, nullptr, TG / LNR, gam, bet, lane); }
            } else {
                const int l = (r - 1) / PH_PER_LAYER, s = (r - 1) % PH_PER_LAYER;
                unsigned char* lw = ws + (size_t)l * LW_SIZE;
                bf16_t* Z = (bf16_t*)(ws + WS_Z);
                switch (s) {
                case 0: {
                    pg8::Gemm gm{XN, D, (const bf16_t*)(lw + LW_WIN), TG, NZ, D}; pg8::StaticOrder S; S.init(TG, NZ, G, b, WGM_BIG);
                    pg8::EpiZ E{Z, (const float*)(lw + LW_BIAS)};
                    pg8::gemm_phase(lds, gm, S, E, tid);
                } break;
                case 1: {
                    {
                        GlaCtx gc{Z, AIN(I_WG2) + (size_t)l * 2 * 16 * 512, AIN(I_BG) + (size_t)l * 2 * 512, (bf16_t*)(ws + WS_OF), (bf16_t*)(ws + WS_OK),
                                  (bf16_t*)(ws + WS_QDG), (bf16_t*)(ws + WS_KDG), (bf16_t*)(ws + WS_KETG), (float*)(ws + WS_DECG), (bf16_t*)(ws + WS_ATTG), SL};
                        for (int u = b; u < NCKG * 8; u += G) {
                            const int dir = u & 1, h = (u >> 1) & 3, ck = u >> 3;
                            if (dir) gla_pre<1>(lds, gc, ck, h, tid); else gla_pre<0>(lds, gc, ck, h, tid);
                        }
                    }
                    RgCtx rc{Z, AIN(I_CRW) + (size_t)l * 4 * DRNN, AIN(I_CRB) + (size_t)l * DRNN, (const bf16_t*)(lw + LW_RGW), AIN(I_RBA) + (size_t)l * 2 * DRNN,
                             AIN(I_RBX) + (size_t)l * 2 * DRNN, AIN(I_LAM) + (size_t)l * 2 * DRNN, (float*)(ws + WS_CARRY), (bf16_t*)(ws + WS_HA), SL};
                    rg_phase<0>(lds, rc, b, G, tid);
                } break;
                case 2: {
                    const int nseq = TG / SL, ngla = nseq * 32;
                    {
                        GlaCtx gc{Z, AIN(I_WG2) + (size_t)l * 2 * 16 * 512, AIN(I_BG) + (size_t)l * 2 * 512, (bf16_t*)(ws + WS_OF), (bf16_t*)(ws + WS_OK),
                                  (bf16_t*)(ws + WS_QDG), (bf16_t*)(ws + WS_KDG), (bf16_t*)(ws + WS_KETG), (float*)(ws + WS_DECG), (bf16_t*)(ws + WS_ATTG), SL};
                        for (int u = b; u < ngla; u += G) {
                            const int sl = (u >> 3) & 3, idx = (u & 7) | ((u >> 5) << 3), dir = idx & 1, h = (idx >> 1) & 3, seq = idx >> 3;
                            if (dir) gla_seq<1>(lds, gc, seq, h, sl, tid); else gla_seq<0>(lds, gc, seq, h, sl, tid);
                        }
                    }
                    RgCtx rc{Z, AIN(I_CRW) + (size_t)l * 4 * DRNN, AIN(I_CRB) + (size_t)l * DRNN, (const bf16_t*)(lw + LW_RGW), AIN(I_RBA) + (size_t)l * 2 * DRNN,
                             AIN(I_RBX) + (size_t)l * 2 * DRNN, AIN(I_LAM) + (size_t)l * 2 * DRNN, (float*)(ws + WS_CARRY), (bf16_t*)(ws + WS_HA), SL};
                    int w0 = 0, nw = G;
                    if (ngla <= G / 2) { w0 = ngla; nw = G - ngla; }
                    if (b >= w0) rg_phase<1>(lds, rc, b - w0, nw, tid);
                } break;
                case 3: {
                    gla_finalize(Z, (const bf16_t*)(ws + WS_OF), (const bf16_t*)(ws + WS_OK), AIN(I_NW) + (size_t)l * 256, (bf16_t*)(ws + WS_OB), G, b, tid);
                } break;
                case 4: {
                    { pg8::Gemm gm{(const bf16_t*)(ws + WS_HA), DRNN, (const bf16_t*)(lw + LW_WPA), TG, D, DRNN}; pg8::StaticOrder S; S.init(TG, D, G, b, WGM_SMALL);
                      pg8::EpiGate<false> E{Z + ZC_MA, Z + ZC_MA, nullptr}; pg8::gemm_phase(lds, gm, S, E, tid); }
                    { pg8::Gemm gm{(const bf16_t*)(ws + WS_OB), DRNN, (const bf16_t*)(lw + LW_WPB), TG, D, DRNN}; pg8::StaticOrder S; S.init(TG, D, G, b, WGM_SMALL);
                      pg8::EpiGate<true> E{Z + ZC_MA, Z + ZC_MB, Z + ZC_MA}; pg8::gemm_phase(lds, gm, S, E, tid); }
                } break;
                case 5: {
                    pg8::Gemm gm{Z + ZC_MA, LDZ, (const bf16_t*)(lw + LW_WOUT), TG, D, D}; pg8::StaticOrder S; S.init(TG, D, G, b, WGM_SMALL);
                    if (l == 0) { pg8::EpiRes<false> E{X, nullptr, nullptr, nullptr, REPMASK && rep + 1 < nrep}; pg8::gemm_phase(lds, gm, S, E, tid); }
                    else { pg8::EpiRes<true> E{X, (const float*)(ws + WS_STATS), AIN(I_LFG) + (size_t)(l - 1) * D, AIN(I_LFB) + (size_t)(l - 1) * D, REPMASK && rep + 1 < nrep}; pg8::gemm_phase(lds, gm, S, E, tid); }
                } break;
                case 6: {
                    const float* gam = AIN(I_LMG) + (size_t)l * D; const float* bet = AIN(I_LMB) + (size_t)l * D;
                    for (int m = b * 8 + wave; m < TG / LNR; m += G * 8) ln_rows<LNR>(X + (size_t)m * D, nullptr, XN + (size_t)m * D, (float*)(ws + WS_STATS) + 2 * m, TG / LNR, gam, bet, lane);
                } break;
                case 7: {
                    pg8::Gemm gm{XN, D, (const bf16_t*)(lw + LW_WUP), TG, 2 * DFF, D}; pg8::StaticOrder S; S.init(TG, 2 * DFF, G, b, WGM_BIG);
                    pg8::EpiBf16 E{(bf16_t*)(ws + WS_U), 2 * DFF}; pg8::gemm_phase(lds, gm, S, E, tid);
                } break;
                case 8: {
                    ff_elem((const bf16_t*)(ws + WS_U), AIN(I_CFW) + (size_t)l * 3 * DFF, AIN(I_CFB) + (size_t)l * DFF, (bf16_t*)(ws + WS_HDN), SL, G, b, tid);
                } break;
                case 9: {
                    pg8::Gemm gm{(const bf16_t*)(ws + WS_HDN), DFF, (const bf16_t*)(lw + LW_WDN), TG, D, DFF}; pg8::StaticOrder S; S.init(TG, D, G, b, WGM_SMALL);
                    pg8::EpiRes<true> E{X, (const float*)(ws + WS_STATS), AIN(I_LMG) + (size_t)l * D, AIN(I_LMB) + (size_t)l * D, REPMASK && rep + 1 < nrep}; pg8::gemm_phase(lds, gm, S, E, tid);
                } break;
                default: {
                    const float* gam = AIN(I_LFG) + (size_t)l * D; const float* bet = AIN(I_LFB) + (size_t)l * D;
                    for (int m = b * 8 + wave; m < TG / LNR; m += G * 8) { const bool lastl = (l + 1 >= DEPTH);
                        ln_rows<LNR>(X + (size_t)m * D, lastl ? X + (size_t)m * D : nullptr, lastl ? nullptr : XN + (size_t)m * D, (float*)(ws + WS_STATS) + 2 * m, TG / LNR, gam, bet, lane); }
                } break;
                }
            }
        }
        }
        if (p + 1 < hi) {
            if (p == 0) { __syncthreads(); cg::this_grid().sync(); }
            else { KArgs apb = (KArgs)__builtin_amdgcn_kernarg_segment_ptr(); xcd_barrier((unsigned*)(apb->ws + WS_CTL), (volatile LAS unsigned*)(lds + LDS_MISC));
                   if ((REPMASK >> 15) & 1) xcd_barrier((unsigned*)(apb->ws + WS_CTL), (volatile LAS unsigned*)(lds + LDS_MISC)); }
        }
    }
}

extern "C" void kernel_launch(void* const* d_in, const int* in_sizes, int n_in, void* d_out, int out_size, void* d_ws, size_t ws_size, hipStream_t stream) {
    static int grid = 0;
    if (grid == 0) {
        if (n_in != 27 || out_size != TALL * D || ws_size < WS_END) { fprintf(stderr, "kernel_launch: unexpected shapes n_in %d out %d ws %zu (need %zu)\n", n_in, out_size, ws_size, (size_t)WS_END); grid = -1; return; }
        int dev = 0, cus = 0, per_cu = 0;
        hipGetDevice(&dev); hipDeviceGetAttribute(&cus, hipDeviceAttributeMultiprocessorCount, dev);
        if (hipFuncSetAttribute((const void*)mega_fwd, hipFuncAttributeMaxDynamicSharedMemorySize, LDS_BYTES) != hipSuccess) { fprintf(stderr, "hipFuncSetAttribute failed\n"); grid = -1; return; }
        if (hipOccupancyMaxActiveBlocksPerMultiprocessor(&per_cu, (const void*)mega_fwd, 512, LDS_BYTES) != hipSuccess || per_cu < 1) { fprintf(stderr, "occupancy query: %d\n", per_cu); per_cu = 1; }
        (void)hipGetLastError();
        grid = cus * per_cu;
    }
    if (grid < 0) return;
    Args a{};
    for (int i = 0; i < 27; ++i) a.in[i] = (const float*)d_in[i];
    a.out = (float*)d_out; a.ws = (unsigned char*)d_ws;
#if ONE_LAUNCH
    if (hipMemsetAsync((char*)d_ws + WS_CTL, 0, CTL_BYTES, stream) != hipSuccess) { fprintf(stderr, "memset failed\n"); return; }
    a.ph_lo = 0; a.ph_hi = NPH;
    void* args[] = {&a};
    hipError_t e = hipLaunchCooperativeKernel((const void*)mega_fwd, dim3(grid), dim3(512), args, LDS_BYTES, stream);
    if (e != hipSuccess) fprintf(stderr, "cooperative launch failed: %s (grid %d)\n", hipGetErrorString(e), grid);
#else
    for (int p = 0; p < NPH; ++p) {
        a.ph_lo = p; a.ph_hi = p + 1;
        hipLaunchKernelGGL(mega_fwd, dim3(grid), dim3(512), LDS_BYTES, stream, a);
    }
#endif
}
```

```cpp
#include <hip/hip_runtime.h>
#include <hip/hip_cooperative_groups.h>
#include <cstdio>
#include <cstdint>
namespace cg = cooperative_groups;

#ifndef PHMASK
#define PHMASK 0xFFFF
#endif
#define EN(k) (((PHMASK) >> (k)) & 1)
#ifndef WGM_BIG
#define WGM_BIG 5
#endif
#ifndef WGM_SMALL
#define WGM_SMALL 4
#endif
#ifndef LNR
#define LNR 4
#endif
#ifndef REPMASK
#define REPMASK 0
#endif
#ifndef GLA_DBG
#define GLA_DBG 0
#endif
#ifndef ONE_LAUNCH
#define ONE_LAUNCH 1
#endif

#define LAS __attribute__((address_space(3)))
typedef unsigned short bf16_t;
typedef short bf16x8 __attribute__((ext_vector_type(8)));
typedef float f32x4 __attribute__((ext_vector_type(4)));
typedef float f32x2 __attribute__((ext_vector_type(2)));
typedef unsigned u32x4 __attribute__((ext_vector_type(4)));
typedef unsigned u32x2 __attribute__((ext_vector_type(2)));

constexpr int D = 2048, TALL = 49152, NG = 3, TG = 16384, LDZ = 9248, NZ = 9472, DRNN = 1024, DFF = 6144, DEPTH = 2;
constexpr int ZC_RX = 0, ZC_RG = 1024, ZC_Q = 2048, ZC_K = 2560, ZC_V = 3072, ZC_OG = 4096, ZC_MA = 5120, ZC_MB = 7168, ZC_GF = 9216;
constexpr float ALPHA = 1.41421356237f, EPS = 1e-5f;
constexpr int PH_PER_LAYER = 11, PH_PER_GROUP = 1 + DEPTH * PH_PER_LAYER, NPH = 1 + NG * PH_PER_GROUP;

constexpr size_t MiB = 1u << 20;
constexpr size_t WIN_B = (size_t)NZ * D * 2, WUP_B = (size_t)2 * DFF * D * 2, WDN_B = (size_t)D * DFF * 2, WOUT_B = (size_t)D * D * 2, WPA_B = (size_t)D * DRNN * 2;
constexpr size_t RGW_B = (size_t)2 * 2 * 16 * 64 * 64 * 2, BIASP_B = 65536;
constexpr size_t LW_WIN = 0, LW_WUP = LW_WIN + WIN_B, LW_WDN = LW_WUP + WUP_B, LW_WOUT = LW_WDN + WDN_B, LW_WPA = LW_WOUT + WOUT_B, LW_WPB = LW_WPA + WPA_B,
                 LW_RGW = LW_WPB + WPA_B, LW_BIAS = LW_RGW + RGW_B, LW_SIZE = LW_BIAS + BIASP_B;
constexpr size_t WS_XN = DEPTH * LW_SIZE, WS_CARRY = WS_XN + 64 * MiB, WS_R = WS_CARRY + 2 * MiB;
constexpr size_t WS_Z = WS_R, WS_HA = WS_R + 289 * MiB, WS_OB = WS_HA + 32 * MiB, WS_OF = WS_OB + 32 * MiB, WS_OK = WS_OF + 32 * MiB;
constexpr size_t WS_QDG = WS_OK + 32 * MiB, WS_KDG = WS_QDG + 32 * MiB, WS_KETG = WS_KDG + 32 * MiB, WS_DECG = WS_KETG + 32 * MiB, WS_ATTG = WS_DECG + 1 * MiB;
constexpr size_t WS_U = WS_R, WS_HDN = WS_R + 384 * MiB, WS_CTL = WS_R + 576 * MiB, CTL_BYTES = 65536, WS_STATS = WS_CTL + CTL_BYTES  , WS_END = WS_STATS + (size_t)TG * 8;
static_assert((size_t)TG * LDZ * 2 == 289 * MiB, "z size");
static_assert(LW_SIZE % 256 == 0, "align");

constexpr int LDS_BYTES = 147456;

typedef __bf16 bf16x2_t __attribute__((ext_vector_type(2)));
__device__ __forceinline__ unsigned cvt_pk_bf16(float lo, float hi) { f32x2 v = {lo, hi}; bf16x2_t b = __builtin_convertvector(v, bf16x2_t); return __builtin_bit_cast(unsigned, b); }
__device__ __forceinline__ float bflo(unsigned w) { return __uint_as_float(w << 16); }
__device__ __forceinline__ float bfhi(unsigned w) { return __uint_as_float(w & 0xffff0000u); }
__device__ __forceinline__ float bf2f(unsigned short h) { return __uint_as_float((unsigned)h << 16); }
__device__ __forceinline__ unsigned short f2bf(float f) { return (unsigned short)(cvt_pk_bf16(f, 0.f) & 0xffffu); }
__device__ __forceinline__ float sigmoid_f(float x) { return __builtin_amdgcn_rcpf(1.f + __expf(-x)); }
__device__ __forceinline__ float gelu_tanh(float v) { return v * sigmoid_f(1.5957691216f * (v + 0.044715f * v * v * v)); }
__device__ __forceinline__ float wave_sum(float v) {
#pragma unroll
    for (int o = 1; o < 64; o <<= 1) v += __shfl_xor(v, o);
    return v;
}
__device__ __forceinline__ void unpack8(u32x4 w, float (&f)[8]) {
    f[0] = bflo(w.x); f[1] = bfhi(w.x); f[2] = bflo(w.y); f[3] = bfhi(w.y); f[4] = bflo(w.z); f[5] = bfhi(w.z); f[6] = bflo(w.w); f[7] = bfhi(w.w);
}
__device__ __forceinline__ u32x4 pack8(const float (&f)[8]) {
    u32x4 w; w.x = cvt_pk_bf16(f[0], f[1]); w.y = cvt_pk_bf16(f[2], f[3]); w.z = cvt_pk_bf16(f[4], f[5]); w.w = cvt_pk_bf16(f[6], f[7]); return w;
}
#define WG_BARRIER() __syncthreads()

namespace pg8 {
constexpr int BM = 256, BK = 64, HALF = 128, HTB = HALF * BK * 2, STAGE_BYTES = 8 * HTB, NXCD = 8, WGM = 8;
__host__ __device__ __forceinline__ int lds_byte(int r, int c) { const int st = (r >> 4) * 2 + (c >> 5), rr = r & 15, cc = c & 31, ob = rr * 64 + cc * 2; return st * 1024 + (ob ^ (((ob >> 9) & 1) << 5)); }
__host__ __device__ __forceinline__ void stage_rc(int b, int& R, int& C) { const int st = b / 1024, sb = b % 1024, swz = sb ^ (((sb >> 9) & 1) << 5); R = (st >> 1) * 16 + swz / 64; C = (st & 1) * 32 + (swz % 64) / 2; }
__host__ __device__ __forceinline__ int perm32(int rho) { const int n = rho >> 4, i = rho & 15; return 8 * (i >> 2) + 4 * n + (i & 3); }

struct Unit { int pm, pn; };
struct Gemm { const bf16_t* A; int lda; const bf16_t* Bt; int M, N, K; };

struct StaticOrder {
    int nM, nN, nwg, G, c, wgm;
    __device__ void init(int M, int N, int G_, int c_, int wgm_ = WGM) { nM = M / BM; nN = N / BM; nwg = nM * nN; G = G_; c = c_; wgm = wgm_; }
    __device__ bool next(int i, Unit& u) const {
        const long L = (long)i * G + c; if (L >= nwg) return false;
        int wgid = (int)L; { const int q = nwg / NXCD, r = nwg % NXCD, xcd = wgid % NXCD, off = wgid / NXCD; wgid = (xcd < r ? xcd * (q + 1) : r * (q + 1) + (xcd - r) * q) + off; }
        const int nig = wgm * nN, gid = wgid / nig, fm = gid * wgm, gsz = (nM - fm) < wgm ? (nM - fm) : wgm;
        u.pm = fm + ((wgid % nig) % gsz); u.pn = (wgid % nig) / gsz; return true;
    }
};

template <class Epi, class Sched>
__device__ __forceinline__ void gemm_phase(LAS unsigned char* lds, const Gemm g, const Sched& S, const Epi& E, const int tid) {
    const int wid = __builtin_amdgcn_readfirstlane(tid >> 6), lane = tid & 63, wr = wid >> 2, wc = wid & 3, fr = lane & 15, fq = lane >> 4;
    const int K = g.K, nt = K / BK, lda = g.lda;
    unsigned voffA[2], voffB[2];
#pragma unroll
    for (int i = 0; i < 2; ++i) { int R, C; stage_rc(tid * 16 + i * 8192, R, C); const int Rb = Epi::PERM ? ((R & ~31) + perm32(R & 31)) : R;
        voffA[i] = (unsigned)(R * lda + C) * 2u; voffB[i] = (unsigned)(Rb * K + C) * 2u; }
    const size_t kstep = (size_t)(BK * 2);
    const size_t hstepA = (size_t)HALF * lda * 2, hstepB = (size_t)HALF * K * 2;
    const size_t tstepA = 2 * hstepA, tstepB = 2 * hstepB;
    const unsigned ldsw = (unsigned)wid * 1024u;
    const int aoff = lds_byte(wr * 64 + fr, fq * 8), boff = lds_byte(wc * 32 + fr, fq * 8);
#define PG8_SA(b, h) (((b) * 2 + (h)) * HTB)
#define PG8_SB(b, h) ((4 + (b) * 2 + (h)) * HTB)
#define PG8_STAGE(bufoff, gbase, voff) do { _Pragma("unroll") for (int _i = 0; _i < 2; ++_i) \
        __builtin_amdgcn_global_load_lds((const unsigned*)((const char*)(gbase) + (voff)[_i]), (LAS unsigned*)(lds + (bufoff) + ldsw + _i * 8192), 16, 0, 0); } while (0)
#define PG8_LDA(dst, b, h) do { _Pragma("unroll") for (int m = 0; m < 4; ++m) _Pragma("unroll") for (int k = 0; k < 2; ++k) dst[m][k] = *(const LAS bf16x8*)(lds + PG8_SA(b, h) + aoff + m * 2048 + k * 1024); } while (0)
#define PG8_LDB(dst, b, h) do { _Pragma("unroll") for (int n = 0; n < 2; ++n) _Pragma("unroll") for (int k = 0; k < 2; ++k) dst[n][k] = *(const LAS bf16x8*)(lds + PG8_SB(b, h) + boff + n * 2048 + k * 1024); } while (0)
#define PG8_MMA(ai, bj, At, Bt) do { __builtin_amdgcn_s_setprio(1); _Pragma("unroll") for (int m = 0; m < 4; ++m) _Pragma("unroll") for (int n = 0; n < 2; ++n) _Pragma("unroll") for (int k = 0; k < 2; ++k) \
        acc[ai][bj][m][n] = __builtin_amdgcn_mfma_f32_16x16x32_bf16(Bt[n][k], At[m][k], acc[ai][bj][m][n], 0, 0, 0); __builtin_amdgcn_s_setprio(0); } while (0)
#define PG8_WAIT_V(n) asm volatile("s_waitcnt vmcnt(" #n ")" ::: "memory")
#define PG8_WAIT_L(n) asm volatile("s_waitcnt lgkmcnt(" #n ")" ::: "memory")
#define PG8_BAR __builtin_amdgcn_s_barrier()
#define PG8_SCHED __builtin_amdgcn_sched_barrier(0)
    Unit cur, nxt; int ui = 0;
    if (!S.next(0, cur)) return;
    f32x4 acc[2][2][4][2];
#pragma unroll
    for (int a = 0; a < 2; ++a)
#pragma unroll
        for (int b = 0; b < 2; ++b)
#pragma unroll
            for (int m = 0; m < 4; ++m)
#pragma unroll
                for (int n = 0; n < 2; ++n) acc[a][b][m][n] = (f32x4){0.f, 0.f, 0.f, 0.f};
    bf16x8 At[4][2], B0[2][2], B1[2][2];
    const char* cA = (const char*)g.A + (size_t)cur.pm * tstepA; const char* cB = (const char*)g.Bt + (size_t)cur.pn * tstepB;
    PG8_STAGE(PG8_SB(0, 0), cB, voffB); PG8_STAGE(PG8_SB(0, 1), cB + hstepB, voffB); PG8_STAGE(PG8_SA(0, 0), cA, voffA); PG8_STAGE(PG8_SA(0, 1), cA + hstepA, voffA);
    if (wr == 1) PG8_BAR;
    PG8_WAIT_V(2); PG8_BAR;
    PG8_STAGE(PG8_SB(1, 0), cB + kstep, voffB); PG8_STAGE(PG8_SA(1, 0), cA + kstep, voffA); PG8_STAGE(PG8_SB(1, 1), cB + hstepB + kstep, voffB);
    PG8_WAIT_V(6); PG8_BAR;
    for (;;) {
        const bool has_next = S.next(ui + 1, nxt);
        const char* nA = has_next ? (const char*)g.A + (size_t)nxt.pm * tstepA : cA; const char* nB = has_next ? (const char*)g.Bt + (size_t)nxt.pn * tstepB : cB;
        for (int t = 0; t < nt; t += 2) {
            const bool last = (t == nt - 2);
            const char* a1 = cA + (size_t)(t + 1) * kstep;
            const char* a2 = last ? nA : cA + (size_t)(t + 2) * kstep; const char* b2 = last ? nB : cB + (size_t)(t + 2) * kstep;
            const char* a3 = a2 + kstep; const char* b3 = b2 + kstep;
            PG8_LDB(B0, 0, 0); PG8_LDB(B1, 0, 1); PG8_SCHED; PG8_LDA(At, 0, 0); PG8_STAGE(PG8_SA(1, 1), a1 + hstepA, voffA);
            PG8_WAIT_V(8); PG8_WAIT_L(0); PG8_BAR; PG8_MMA(0, 0, At, B0); PG8_MMA(0, 1, At, B1); PG8_BAR; PG8_SCHED;
            PG8_LDA(At, 0, 1); PG8_STAGE(PG8_SB(0, 0), b2, voffB); PG8_STAGE(PG8_SB(0, 1), b2 + hstepB, voffB); PG8_STAGE(PG8_SA(0, 0), a2, voffA);
            PG8_WAIT_V(8); PG8_WAIT_L(0); PG8_BAR; PG8_MMA(1, 0, At, B0); PG8_MMA(1, 1, At, B1); PG8_BAR; PG8_SCHED;
            PG8_LDB(B0, 1, 0); PG8_LDB(B1, 1, 1); PG8_SCHED; PG8_LDA(At, 1, 0); PG8_STAGE(PG8_SA(0, 1), a2 + hstepA, voffA);
            PG8_WAIT_V(8); PG8_WAIT_L(0); PG8_BAR; PG8_MMA(0, 0, At, B0); PG8_MMA(0, 1, At, B1); PG8_BAR; PG8_SCHED;
            PG8_LDA(At, 1, 1); PG8_STAGE(PG8_SB(1, 0), b3, voffB); PG8_STAGE(PG8_SB(1, 1), b3 + hstepB, voffB); PG8_STAGE(PG8_SA(1, 0), a3, voffA);
            PG8_WAIT_V(8); PG8_WAIT_L(0); PG8_BAR; PG8_MMA(1, 0, At, B0); PG8_MMA(1, 1, At, B1); PG8_BAR; PG8_SCHED;
        }
        if (wr == 0) PG8_BAR;
        E(acc, cur, wr, wc, fr, fq);
        if (!has_next) break;
#pragma unroll
        for (int a = 0; a < 2; ++a)
#pragma unroll
            for (int b = 0; b < 2; ++b)
#pragma unroll
                for (int m = 0; m < 4; ++m)
#pragma unroll
                    for (int n = 0; n < 2; ++n) acc[a][b][m][n] = (f32x4){0.f, 0.f, 0.f, 0.f};
        cur = nxt; cA = nA; cB = nB; ++ui;
        if (wr == 1) PG8_BAR;
    }
    PG8_WAIT_V(0);
    PG8_BAR;
#undef PG8_SA
#undef PG8_SB
#undef PG8_STAGE
#undef PG8_LDA
#undef PG8_LDB
#undef PG8_MMA
#undef PG8_WAIT_V
#undef PG8_WAIT_L
#undef PG8_BAR
#undef PG8_SCHED
}

struct EpiZ {
    static constexpr bool PERM = true;
    bf16_t* Z; const float* bias;
    __device__ __forceinline__ void operator()(const f32x4 (&acc)[2][2][4][2], const Unit& u, int wr, int wc, int fr, int fq) const {
        const int pn = u.pn;
        int mode = 0;
        if (pn == 8 || pn == 9) mode = 2; else if (pn >= 20 && pn < 36) mode = 4;
        const bool tail = (pn == 36);
        if (tail && wc != 0) return;
        const int row0 = u.pm * BM + wr * 64 + fr; const int col0 = pn * BM + wc * 32 + 8 * fq;
#pragma unroll
        for (int bj = 0; bj < 2; ++bj) {
            if (tail && bj == 1) break;
            const f32x4 b0 = *(const f32x4*)(bias + col0 + bj * HALF), b1 = *(const f32x4*)(bias + col0 + bj * HALF + 4);
#pragma unroll
            for (int ai = 0; ai < 2; ++ai)
#pragma unroll
                for (int m = 0; m < 4; ++m) {
                    f32x4 v0 = acc[ai][bj][m][0] + b0, v1 = acc[ai][bj][m][1] + b1;
                    float f[8] = {v0[0], v0[1], v0[2], v0[3], v1[0], v1[1], v1[2], v1[3]};
                    if (mode == 1) {
#pragma unroll
                        for (int e = 0; e < 8; ++e) f[e] = gelu_tanh(f[e]);
                    } else if (mode == 2) {
#pragma unroll
                        for (int e = 0; e < 8; ++e) f[e] *= 0.08838834764831845f;
                    } else if (mode == 3) {
#pragma unroll
                        for (int e = 0; e < 8; ++e) f[e] = f[e] * sigmoid_f(f[e]);
                    } else if (mode == 4) {
#pragma unroll
                        for (int e = 0; e < 8; ++e) f[e] = sigmoid_f(f[e]);
                    }
                    __builtin_nontemporal_store(pack8(f), (u32x4*)(Z + (size_t)(row0 + ai * HALF + m * 16) * LDZ + col0 + bj * HALF));
                }
        }
    }
};
template <bool HAS_ADD> struct EpiGate {
    static constexpr bool PERM = true;
    bf16_t* dst; const bf16_t* gate; const bf16_t* add;
    __device__ __forceinline__ void operator()(const f32x4 (&acc)[2][2][4][2], const Unit& u, int wr, int wc, int fr, int fq) const {
        const int row0 = u.pm * BM + wr * 64 + fr; const int col0 = u.pn * BM + wc * 32 + 8 * fq;
#pragma unroll
        for (int ai = 0; ai < 2; ++ai)
#pragma unroll
          for (int mh = 0; mh < 2; ++mh) {
            u32x4 gv[4][2], av[4][2];
#pragma unroll
            for (int m = 2 * mh; m < 2 * mh + 2; ++m)
#pragma unroll
                for (int bj = 0; bj < 2; ++bj) {
                    const size_t off = (size_t)(row0 + ai * HALF + m * 16) * LDZ + col0 + bj * HALF;
                    gv[m][bj] = *(const u32x4*)(gate + off);
                    if (HAS_ADD) av[m][bj] = *(const u32x4*)(add + off);
                }
#pragma unroll
            for (int m = 2 * mh; m < 2 * mh + 2; ++m)
#pragma unroll
                for (int bj = 0; bj < 2; ++bj) {
                    const size_t off = (size_t)(row0 + ai * HALF + m * 16) * LDZ + col0 + bj * HALF;
                    float gt[8]; unpack8(gv[m][bj], gt);
                    const f32x4 v0 = acc[ai][bj][m][0], v1 = acc[ai][bj][m][1];
                    float f[8] = {v0[0] * gt[0], v0[1] * gt[1], v0[2] * gt[2], v0[3] * gt[3], v1[0] * gt[4], v1[1] * gt[5], v1[2] * gt[6], v1[3] * gt[7]};
                    if (HAS_ADD) { float ad[8]; unpack8(av[m][bj], ad);
#pragma unroll
                        for (int e = 0; e < 8; ++e) f[e] += ad[e]; }
                    *(u32x4*)(dst + off) = pack8(f);
                }
        }
    }
};
template <bool NORM> struct EpiRes {
    static constexpr bool PERM = false;
    float* X; const float* stats; const float* gam; const float* bet; bool dry;
    __device__ __forceinline__ void operator()(const f32x4 (&acc)[2][2][4][2], const Unit& u, int wr, int wc, int fr, int fq) const {
        const int row0 = u.pm * BM + wr * 64 + fr; const int col0 = u.pn * BM + wc * 32 + 4 * fq;
#pragma unroll
        for (int bj = 0; bj < 2; ++bj)
#pragma unroll
            for (int n = 0; n < 2; ++n) {
                const int col = col0 + bj * HALF + n * 16;
                f32x4 gg = {1.f, 1.f, 1.f, 1.f}, bb = {0.f, 0.f, 0.f, 0.f};
                if (NORM) { gg = *(const f32x4*)(gam + col); bb = *(const f32x4*)(bet + col); }
#pragma unroll
                for (int ai = 0; ai < 2; ++ai) {
                    f32x4 xv[4]; f32x2 st[4];
#pragma unroll
                    for (int m = 0; m < 4; ++m) { xv[m] = *(const f32x4*)(X + (size_t)(row0 + ai * HALF + m * 16) * D + col);
                        if (NORM) st[m] = *(const f32x2*)(stats + 2 * (row0 + ai * HALF + m * 16)); }
#pragma unroll
                    for (int m = 0; m < 4; ++m) {
                        f32x4 x = xv[m];
                        if (NORM) x = (x - st[m].x) * st[m].y * gg + bb;
                        if (!dry) *(f32x4*)(X + (size_t)(row0 + ai * HALF + m * 16) * D + col) = x * ALPHA + acc[ai][bj][m][n];
                    }
                }
            }
    }
};
struct EpiBf16 {
    static constexpr bool PERM = true;
    bf16_t* O; int ld;
    __device__ __forceinline__ void operator()(const f32x4 (&acc)[2][2][4][2], const Unit& u, int wr, int wc, int fr, int fq) const {
        const int row0 = u.pm * BM + wr * 64 + fr; const int col0 = u.pn * BM + wc * 32 + 8 * fq;
#pragma unroll
        for (int ai = 0; ai < 2; ++ai)
#pragma unroll
            for (int m = 0; m < 4; ++m)
#pragma unroll
                for (int bj = 0; bj < 2; ++bj) {
                    const f32x4 v0 = acc[ai][bj][m][0], v1 = acc[ai][bj][m][1];
                    u32x4 w; w.x = cvt_pk_bf16(v0[0], v0[1]); w.y = cvt_pk_bf16(v0[2], v0[3]); w.z = cvt_pk_bf16(v1[0], v1[1]); w.w = cvt_pk_bf16(v1[2], v1[3]);
                    __builtin_nontemporal_store(w, (u32x4*)(O + (size_t)(row0 + ai * HALF + m * 16) * ld + col0 + bj * HALF));
                }
    }
};
}


#define XB_TMO      128
#define XB_XCNT(j)  (256  + 64 * (j))
#define XB_XSUB(j)  (1280 + 64 * (j))
#define XB_XGEN(j)  (2304 + 64 * (j))
#define XB_TOP      3328
#define XB_TOPGEN   3392
#define XCD_BAR_WORDS 3456
#define XB_SPIN_CAP (1u << 22)
__device__ __forceinline__ unsigned xb_ld(unsigned* p)              { return __hip_atomic_load(p, __ATOMIC_RELAXED, __HIP_MEMORY_SCOPE_AGENT); }
__device__ __forceinline__ unsigned xb_add(unsigned* p, unsigned v) { return __hip_atomic_fetch_add(p, v, __ATOMIC_RELAXED, __HIP_MEMORY_SCOPE_AGENT); }
__device__ __forceinline__ unsigned xb_xcc_id() { return (unsigned)__builtin_amdgcn_s_getreg((3 << 11) | 20) & 0xFu; }
#define XB_SPIN(cond, bar) do { unsigned _sp = 0; while (cond) { __builtin_amdgcn_s_sleep(1); \
    if ((++_sp & 255u) == 0u) { if (xb_ld(&(bar)[XB_TMO])) break; if (_sp > XB_SPIN_CAP) { atomicAdd(&(bar)[XB_TMO], 1u); break; } } } } while (0)
__device__ __forceinline__ void xcd_barrier_complete(unsigned* bar, unsigned x, unsigned& nloc, unsigned& nx) {
    const unsigned G = gridDim.x * gridDim.y * gridDim.z;
    unsigned sum, cnt, mine, sp = 0u;
    for (;;) {
        sum = 0u; cnt = 0u; mine = 0u;
#pragma unroll
        for (unsigned j = 0; j < 16; ++j) { const unsigned c = xb_ld(&bar[XB_XCNT(j)]); sum += c; cnt += (c > 0u) ? 1u : 0u; mine = (j == x) ? c : mine; }
        if (sum == G) break;
        __builtin_amdgcn_s_sleep(1);
        if ((++sp & 255u) == 0u) { if (xb_ld(&bar[XB_TMO])) break; if (sp > XB_SPIN_CAP) { atomicAdd(&bar[XB_TMO], 1u); break; } }
    }
    nloc = mine > 0u ? mine : 1u; nx = cnt > 0u ? cnt : 1u;
}
__device__ __forceinline__ void xcd_barrier(unsigned* bar, volatile LAS unsigned* st) {
    asm volatile("s_waitcnt vmcnt(0)" ::: "memory");
    __syncthreads();
    if (threadIdx.x == 0) {
        const unsigned x = xb_xcc_id();
        __builtin_amdgcn_s_waitcnt(0);
        unsigned nloc = st[0], nx = st[1];
        if (nloc == 0u) { xcd_barrier_complete(bar, x, nloc, nx); st[0] = nloc; st[1] = nx; }
        const unsigned old = xb_add(&bar[XB_XSUB(x)], 1u);
        const unsigned gen = old / nloc;
        if (old + 1u == (gen + 1u) * nloc) {
            __builtin_amdgcn_fence(__ATOMIC_RELEASE, "agent");
            asm volatile("s_waitcnt vmcnt(0)" ::: "memory");
            const unsigned og = xb_add(&bar[XB_TOP], 1u);
            const unsigned tg = og / nx;
            if (og + 1u == (tg + 1u) * nx) xb_add(&bar[XB_TOPGEN], 1u);
            else XB_SPIN(xb_ld(&bar[XB_TOPGEN]) == tg, bar);
            __builtin_amdgcn_fence(__ATOMIC_ACQUIRE, "agent");
            xb_add(&bar[XB_XGEN(x)], 1u);
            asm volatile("s_waitcnt vmcnt(0)" ::: "memory");
        } else {
            XB_SPIN(xb_ld(&bar[XB_XGEN(x)]) == gen, bar);
            __builtin_amdgcn_fence(__ATOMIC_ACQUIRE, "agent");
            asm volatile("s_waitcnt vmcnt(0)" ::: "memory");
        }
    }
    __syncthreads();
}
constexpr int LDS_MISC = LDS_BYTES - 64;

struct Args { const float* in[27]; float* out; unsigned char* ws; int ph_lo, ph_hi; };
static_assert(sizeof(Args) == 27 * 8 + 8 + 8 + 8, "no padding");
enum { I_XP = 0, I_XS, I_LNIG, I_LNIB, I_WIN, I_BIN, I_CRW, I_CRB, I_RWA, I_RBA, I_RWX, I_RBX, I_LAM, I_WG2, I_BG, I_NW, I_WPA, I_WPB, I_WOUT, I_LMG, I_LMB, I_WUP, I_CFW, I_CFB, I_WDN, I_LFG, I_LFB };

__device__ __forceinline__ void transpose_item(const float* W, int K, int N, bf16_t* WT, int k0, int n0, int drow, LAS float* scr, int lane) {
#pragma unroll 8
    for (int i = 0; i < 32; ++i) { const int kk = 2 * i + (lane >> 5); scr[kk * 33 + (lane & 31)] = W[(size_t)(k0 + kk) * N + n0 + (lane & 31)]; }
    asm volatile("s_waitcnt lgkmcnt(0)" ::: "memory");
    const int c = lane & 7;
#pragma unroll
    for (int j = 0; j < 4; ++j) { const int n = (lane >> 3) + 8 * j; const LAS float* s = scr + (8 * c) * 33 + n;
        u32x4 o; o.x = cvt_pk_bf16(s[0 * 33], s[1 * 33]); o.y = cvt_pk_bf16(s[2 * 33], s[3 * 33]); o.z = cvt_pk_bf16(s[4 * 33], s[5 * 33]); o.w = cvt_pk_bf16(s[6 * 33], s[7 * 33]);
        *(u32x4*)(WT + (size_t)(drow + n) * K + k0 + 8 * c) = o; }
    asm volatile("s_waitcnt lgkmcnt(0)" ::: "memory");
}
__device__ __forceinline__ int win_colmap(int n) { return n < 5120 ? n : (n < 5152 ? n + 4096 : n - 32); }

__device__ __forceinline__ void phase_convert(const Args& a, LAS unsigned char* lds, int G, int b, int tid) {
    const int wave = tid >> 6, lane = tid & 63;
    LAS float* scr = (LAS float*)(lds + wave * 16384);
    const int gw = b * 8 + wave, NGW = G * 8;
    constexpr int I_IN = 32 * 289, I_UP = 32 * 384, I_DN = 96 * 64, I_OUT = 32 * 64, I_PA = 16 * 64, I_L = I_IN + I_UP + I_DN + I_OUT + 2 * I_PA;
    for (int it = gw; it < DEPTH * I_L; it += NGW) {
        const int l = it / I_L; int r = it % I_L;
        unsigned char* lw = a.ws + (size_t)l * LW_SIZE;
        if (r < I_IN) { const int kb = r / 289, nb = r % 289; transpose_item(a.in[I_WIN] + (size_t)l * D * LDZ, D, LDZ, (bf16_t*)(lw + LW_WIN), kb * 64, nb * 32, win_colmap(nb * 32), scr, lane); continue; } r -= I_IN;
        if (r < I_UP) { const int kb = r / 384, nb = r % 384; transpose_item(a.in[I_WUP] + (size_t)l * D * 2 * DFF, D, 2 * DFF, (bf16_t*)(lw + LW_WUP), kb * 64, nb * 32, nb * 32, scr, lane); continue; } r -= I_UP;
        if (r < I_DN) { const int kb = r / 64, nb = r % 64; transpose_item(a.in[I_WDN] + (size_t)l * DFF * D, DFF, D, (bf16_t*)(lw + LW_WDN), kb * 64, nb * 32, nb * 32, scr, lane); continue; } r -= I_DN;
        if (r < I_OUT) { const int kb = r / 64, nb = r % 64; transpose_item(a.in[I_WOUT] + (size_t)l * D * D, D, D, (bf16_t*)(lw + LW_WOUT), kb * 64, nb * 32, nb * 32, scr, lane); continue; } r -= I_OUT;
        if (r < I_PA) { const int kb = r / 64, nb = r % 64; transpose_item(a.in[I_WPA] + (size_t)l * DRNN * D, DRNN, D, (bf16_t*)(lw + LW_WPA), kb * 64, nb * 32, nb * 32, scr, lane); continue; } r -= I_PA;
        { const int kb = r / 64, nb = r % 64; transpose_item(a.in[I_WPB] + (size_t)l * DRNN * D, DRNN, D, (bf16_t*)(lw + LW_WPB), kb * 64, nb * 32, nb * 32, scr, lane); }
    }
    const int gt = b * 512 + tid, NT = G * 512;
    for (int i = gt; i < DEPTH * 224 * 256; i += NT) { const int l = i / (224 * 256), r = i % (224 * 256);
        *(u32x4*)(a.ws + (size_t)l * LW_SIZE + LW_WIN + (size_t)LDZ * D * 2 + (size_t)r * 16) = (u32x4){0u, 0u, 0u, 0u}; }
    for (int i = gt; i < DEPTH * NZ; i += NT) { const int l = i / NZ, n = i % NZ; float* bp = (float*)(a.ws + (size_t)l * LW_SIZE + LW_BIAS);
        if (n >= LDZ) bp[n] = 0.f; else bp[win_colmap(n)] = a.in[I_BIN][(size_t)l * LDZ + n]; }
    for (int i = gt; i < DEPTH * 2 * 2 * 16 * 4096; i += NT) {
        const int ii = i & 63, j = (i >> 6) & 63, n = (i >> 12) & 15, dir = (i >> 16) & 1, which = (i >> 17) & 1, l = i >> 18;
        const float* src = which ? a.in[I_RWX] : a.in[I_RWA];
        const float v = src[((((size_t)l * 2 + dir) * 16 + n) * 64 + ii) * 64 + j];
        ((bf16_t*)(a.ws + (size_t)l * LW_SIZE + LW_RGW))[i & 262143] = f2bf(v);
    }
}

__device__ __forceinline__ void ln_row(const float* src, float* dstf, bf16_t* dstb, const float* gam, const float* bet, int lane, float* stat = nullptr) {
    const f32x4* s4 = (const f32x4*)src + lane;
    f32x4 v[8]; float s = 0.f;
#pragma unroll
    for (int j = 0; j < 8; ++j) { v[j] = s4[64 * j]; s += (v[j].x + v[j].y) + (v[j].z + v[j].w); }
    const float mean = wave_sum(s) * (1.f / D); float s2 = 0.f;
#pragma unroll
    for (int j = 0; j < 8; ++j) { v[j] = v[j] - mean; s2 += (v[j].x * v[j].x + v[j].y * v[j].y) + (v[j].z * v[j].z + v[j].w * v[j].w); }
    const float rstd = 1.f / sqrtf(wave_sum(s2) * (1.f / D) + EPS);
    if (stat && lane == 0) { stat[0] = mean; stat[1] = rstd; }
#pragma unroll
    for (int j = 0; j < 8; ++j) {
        const f32x4 gg = ((const f32x4*)gam)[lane + 64 * j], bb = ((const f32x4*)bet)[lane + 64 * j];
        const f32x4 o = v[j] * rstd * gg + bb;
        if (dstf) ((f32x4*)dstf)[lane + 64 * j] = o;
        if (dstb) { u32x2 w; w.x = cvt_pk_bf16(o.x, o.y); w.y = cvt_pk_bf16(o.z, o.w); ((u32x2*)dstb)[lane + 64 * j] = w; }
    }
}

template <int NR>
__device__ __forceinline__ void ln_rows(const float* src, float* dstf, bf16_t* dstb, float* stat, size_t rstride, const float* gam, const float* bet, int lane) {
    f32x4 v[NR][8]; float mean[NR], rstd[NR];
#pragma unroll
    for (int r = 0; r < NR; ++r)
#pragma unroll
        for (int j = 0; j < 8; ++j) v[r][j] = ((const f32x4*)(src + r * rstride * D))[lane + 64 * j];
#pragma unroll
    for (int r = 0; r < NR; ++r) {
        float s = 0.f;
#pragma unroll
        for (int j = 0; j < 8; ++j) s += (v[r][j].x + v[r][j].y) + (v[r][j].z + v[r][j].w);
        mean[r] = wave_sum(s) * (1.f / D); float s2 = 0.f;
#pragma unroll
        for (int j = 0; j < 8; ++j) { v[r][j] = v[r][j] - mean[r]; s2 += (v[r][j].x * v[r][j].x + v[r][j].y * v[r][j].y) + (v[r][j].z * v[r][j].z + v[r][j].w * v[r][j].w); }
        rstd[r] = 1.f / sqrtf(wave_sum(s2) * (1.f / D) + EPS);
        if (stat && lane == 0) { stat[2 * r * rstride] = mean[r]; stat[2 * r * rstride + 1] = rstd[r]; }
    }
#pragma unroll
    for (int j = 0; j < 8; ++j) {
        const f32x4 gg = ((const f32x4*)gam)[lane + 64 * j], bb = ((const f32x4*)bet)[lane + 64 * j];
#pragma unroll
        for (int r = 0; r < NR; ++r) {
            const f32x4 o = v[r][j] * rstd[r] * gg + bb;
            if (dstf) ((f32x4*)(dstf + r * rstride * D))[lane + 64 * j] = o;
            if (dstb) { u32x2 p; p.x = cvt_pk_bf16(o.x, o.y); p.y = cvt_pk_bf16(o.z, o.w); ((u32x2*)(dstb + r * rstride * D))[lane + 64 * j] = p; }
        }
    }
}

constexpr int RG_XF = 0, RG_XB = 32768, RG_HF = 51200, RG_HB = 83968;
struct RgCtx { const bf16_t* Z; const float* cw; const float* cb; const bf16_t* rgw; const float* ba; const float* bx; const float* lam; float* carry; bf16_t* HA; int SL; };
template <int MODE, int DIR>
__device__ __forceinline__ void rg_wave(LAS unsigned char* lds, const RgCtx& c, int tile, int n, int ct, int lane) {
    const int fr = lane & 15, fq = lane >> 4, cl = 16 * ct + fr, ch = n * 64 + cl;
    bf16x8 Ba[2], Bx[2];
#pragma unroll
    for (int ks = 0; ks < 2; ++ks) {
        Ba[ks] = *(const bf16x8*)(c.rgw + ((((size_t)0 * 2 + DIR) * 16 + n) * 64 + cl) * 64 + 32 * ks + 8 * fq);
        Bx[ks] = *(const bf16x8*)(c.rgw + ((((size_t)1 * 2 + DIR) * 16 + n) * 64 + cl) * 64 + 32 * ks + 8 * fq);
    }
    const float ba = c.ba[DIR * DRNN + ch], bx = c.bx[DIR * DRNN + ch], lam = c.lam[DIR * DRNN + ch];
    const float c8sp = -8.f * log1pf(__expf(-lam));
    float* cA = c.carry + ((size_t)(0 * 2 + DIR) * 128) * DRNN; float* cH = c.carry + ((size_t)(1 * 2 + DIR) * 128) * DRNN;
    float Hc = 0.f, Ac = 1.f;
    if (MODE == 1) {
        const int tps = c.SL / 128, s0 = (tile / tps) * tps;
        const int first = DIR ? s0 + tps - 1 : s0, cnt = DIR ? (s0 + tps - 1 - tile) : (tile - s0);
        for (int k0 = 0; k0 < cnt; k0 += 8) {
            float a8[8], h8[8];
#pragma unroll
            for (int k = 0; k < 8; ++k) { const bool ok = (k0 + k) < cnt; const int pp = DIR ? first - (k0 + k) : first + (k0 + k);
                a8[k] = ok ? cA[(size_t)pp * DRNN + ch] : 1.f; h8[k] = ok ? cH[(size_t)pp * DRNN + ch] : 0.f; }
#pragma unroll
            for (int k = 0; k < 8; ++k) Hc = a8[k] * Hc + h8[k];
        }
    }
    const LAS float* XF = (const LAS float*)(lds + RG_XF);
    LAS float* HO = (LAS float*)(lds + (DIR ? RG_HB : RG_HF));
#pragma unroll 4
    for (int rti = 0; rti < 8; ++rti) {
        const int rt = DIR ? 7 - rti : rti;
        const bf16x8 A0 = *(const LAS bf16x8*)(lds + RG_XB + (16 * rt + fr) * 144 + 16 * fq);
        const bf16x8 A1 = *(const LAS bf16x8*)(lds + RG_XB + (16 * rt + fr) * 144 + 64 + 16 * fq);
        f32x4 racc = {0.f, 0.f, 0.f, 0.f}, iacc = {0.f, 0.f, 0.f, 0.f};
        racc = __builtin_amdgcn_mfma_f32_16x16x32_bf16(A0, Ba[0], racc, 0, 0, 0); racc = __builtin_amdgcn_mfma_f32_16x16x32_bf16(A1, Ba[1], racc, 0, 0, 0);
        iacc = __builtin_amdgcn_mfma_f32_16x16x32_bf16(A0, Bx[0], iacc, 0, 0, 0); iacc = __builtin_amdgcn_mfma_f32_16x16x32_bf16(A1, Bx[1], iacc, 0, 0, 0);
        f32x4 av4, uu4;
        {
            const f32x4 c60 = {60.f, 60.f, 60.f, 60.f};
            const f32x4 ta = __builtin_elementwise_min((racc + ba) * (-1.4426950408889634f), c60), tb = __builtin_elementwise_min((iacc + bx) * (-1.4426950408889634f), c60);
            f32x4 ea, eb;
#pragma unroll
            for (int j = 0; j < 4; ++j) { ea[j] = __builtin_amdgcn_exp2f(ta[j]); eb[j] = __builtin_amdgcn_exp2f(tb[j]); }
            const f32x4 da = ea + 1.f, db = eb + 1.f, dd = da * db;
            f32x4 R;
#pragma unroll
            for (int j = 0; j < 4; ++j) R[j] = __builtin_amdgcn_rcpf(dd[j]);
            const f32x4 r4 = db * R, ig4 = da * R;
            const f32x4 la2 = r4 * (c8sp * 1.4426950408889634f);
#pragma unroll
            for (int j = 0; j < 4; ++j) av4[j] = __builtin_amdgcn_exp2f(la2[j]);
            f32x4 om = 1.f - av4 * av4, xv4;
#pragma unroll
            for (int j = 0; j < 4; ++j) { om[j] = __builtin_amdgcn_sqrtf(fmaxf(om[j], 0.f)); xv4[j] = XF[(16 * rt + 4 * fq + j) * 64 + cl]; }
            uu4 = om * ig4 * xv4;
        }
        float hl[4], al[4]; float hp = 0.f, ap = 1.f;
#pragma unroll
        for (int jj = 0; jj < 4; ++jj) {
            const int j = DIR ? 3 - jj : jj;
            hp = av4[j] * hp + uu4[j]; ap = ap * av4[j]; hl[j] = hp; al[j] = ap;
        }
        float Hrun = Hc, Hin = 0.f, Aall = 1.f;
#pragma unroll
        for (int qq = 0; qq < 4; ++qq) {
            const int q = DIR ? 3 - qq : qq;
            const float Aq = __shfl(ap, fr + 16 * q), Hq = __shfl(hp, fr + 16 * q);
            if (q == fq) Hin = Hrun;
            Hrun = Aq * Hrun + Hq; Aall *= Aq;
        }
        Hc = Hrun; Ac *= Aall;
        if (MODE == 1) {
#pragma unroll
            for (int j = 0; j < 4; ++j) HO[(16 * rt + 4 * fq + j) * 64 + cl] = hl[j] + al[j] * Hin;
        }
    }
    if (MODE == 0 && fq == 0) { cA[(size_t)tile * DRNN + ch] = Ac; cH[(size_t)tile * DRNN + ch] = Hc; }
}

template <int MODE>
__device__ __forceinline__ void rg_tile(LAS unsigned char* lds, const RgCtx& c, int tile, int n, int tid) {
    const int wave = __builtin_amdgcn_readfirstlane(tid >> 6), lane = tid & 63;
    const int t0 = tile * 128;
    {
        const int c8 = tid & 7, tr = tid >> 3, ch0 = n * 64 + c8 * 8;
        f32x4 w[4][2], bb[2];
#pragma unroll
        for (int j = 0; j < 4; ++j) { w[j][0] = *(const f32x4*)(c.cw + j * DRNN + ch0); w[j][1] = *(const f32x4*)(c.cw + j * DRNN + ch0 + 4); }
        bb[0] = *(const f32x4*)(c.cb + ch0); bb[1] = *(const f32x4*)(c.cb + ch0 + 4);
#pragma unroll
        for (int h = 0; h < 2; ++h) {
            const int rr = tr + 64 * h, t = t0 + rr, pos = t & (c.SL - 1);
            float x[8] = {bb[0][0], bb[0][1], bb[0][2], bb[0][3], bb[1][0], bb[1][1], bb[1][2], bb[1][3]};
#pragma unroll
            for (int j = 0; j < 4; ++j) {
                const int pp = pos + j - 2;
                if (pp >= 0 && pp < c.SL) {
                    float zf[8]; unpack8(*(const u32x4*)(c.Z + (size_t)(t + j - 2) * LDZ + ZC_RX + ch0), zf);
#pragma unroll
                    for (int e = 0; e < 8; ++e) x[e] += w[j][e >> 2][e & 3] * zf[e];
                }
            }
            *(LAS f32x4*)(lds + RG_XF + (rr * 64 + c8 * 8) * 4) = (f32x4){x[0], x[1], x[2], x[3]};
            *(LAS f32x4*)(lds + RG_XF + (rr * 64 + c8 * 8 + 4) * 4) = (f32x4){x[4], x[5], x[6], x[7]};
            *(LAS u32x4*)(lds + RG_XB + rr * 144 + c8 * 16) = pack8(x);
        }
    }
    u32x4 gpre[2] = {{0u, 0u, 0u, 0u}, {0u, 0u, 0u, 0u}};
    if (MODE == 1) { const int tok = tid >> 2, cs = (tid & 3) * 16;
#pragma unroll
        for (int h = 0; h < 2; ++h) gpre[h] = *(const u32x4*)(c.Z + (size_t)(t0 + tok) * LDZ + ZC_RG + n * 64 + cs + 8 * h); }
    WG_BARRIER();
    if (wave < 4) rg_wave<MODE, 0>(lds, c, tile, n, wave & 3, lane); else rg_wave<MODE, 1>(lds, c, tile, n, wave & 3, lane);
    WG_BARRIER();
    if (MODE == 1) {
        const int tok = tid >> 2, cs = (tid & 3) * 16;
        const LAS float* hf = (const LAS float*)(lds + RG_HF) + tok * 64 + cs; const LAS float* hb = (const LAS float*)(lds + RG_HB) + tok * 64 + cs;
#pragma unroll
        for (int h = 0; h < 2; ++h) {
            float gt[8]; unpack8(gpre[h], gt);
#pragma unroll
            for (int e = 0; e < 8; ++e) gt[e] = gelu_tanh(gt[e]);
            const f32x4 f0 = *(const LAS f32x4*)(hf + 8 * h), f1 = *(const LAS f32x4*)(hf + 8 * h + 4), b0 = *(const LAS f32x4*)(hb + 8 * h), b1 = *(const LAS f32x4*)(hb + 8 * h + 4);
            float o[8] = {gt[0] * (f0[0] + b0[0]), gt[1] * (f0[1] + b0[1]), gt[2] * (f0[2] + b0[2]), gt[3] * (f0[3] + b0[3]),
                          gt[4] * (f1[0] + b1[0]), gt[5] * (f1[1] + b1[1]), gt[6] * (f1[2] + b1[2]), gt[7] * (f1[3] + b1[3])};
            *(u32x4*)(c.HA + (size_t)(t0 + tok) * DRNN + n * 64 + cs + 8 * h) = pack8(o);
        }
    }
}

template <int MODE>
__device__ __forceinline__ void rg_phase(LAS unsigned char* lds, const RgCtx& c, int u0, int ustride, int tid) {
    constexpr int NU = 128 * 16;
    if (u0 >= NU) return;
    const int wave = __builtin_amdgcn_readfirstlane(tid >> 6), lane = tid & 63;
    const int c8 = tid & 7, tr = tid >> 3;
    u32x4 zr[2][4];
#define RG_LOAD(u_) do { const int tile_ = (u_) >> 4, ch0_ = ((u_) & 15) * 64 + c8 * 8; \
        _Pragma("unroll") for (int hh = 0; hh < 2; ++hh) { const int t_ = tile_ * 128 + tr + 64 * hh, pos_ = t_ & (c.SL - 1); \
            _Pragma("unroll") for (int j = 0; j < 4; ++j) { const int pp_ = pos_ + j - 2; const int tt_ = (pp_ >= 0 && pp_ < c.SL) ? t_ + j - 2 : t_;     \
                zr[hh][j] = *(const u32x4*)(c.Z + (size_t)tt_ * LDZ + ZC_RX + ch0_); } } } while (0)
    RG_LOAD(u0);
    const bool nconst = (ustride & 15) == 0;
    f32x4 w[4][2], bb[2];
#define RG_WLOAD(n_) do { const int ch0_ = (n_) * 64 + c8 * 8; \
        _Pragma("unroll") for (int j = 0; j < 4; ++j) { w[j][0] = *(const f32x4*)(c.cw + j * DRNN + ch0_); w[j][1] = *(const f32x4*)(c.cw + j * DRNN + ch0_ + 4); } \
        bb[0] = *(const f32x4*)(c.cb + ch0_); bb[1] = *(const f32x4*)(c.cb + ch0_ + 4); } while (0)
    RG_WLOAD(u0 & 15);
#pragma unroll 1
    for (int u = u0; u < NU; u += ustride) {
        const int tile = u >> 4, n = u & 15, t0 = tile * 128;
        {
            if (!nconst) RG_WLOAD(n);
#pragma unroll
            for (int h = 0; h < 2; ++h) {
                const int rr = tr + 64 * h, t = t0 + rr, pos = t & (c.SL - 1);
                float x[8] = {bb[0][0], bb[0][1], bb[0][2], bb[0][3], bb[1][0], bb[1][1], bb[1][2], bb[1][3]};
#pragma unroll
                for (int j = 0; j < 4; ++j) {
                    const int pp = pos + j - 2;
                    float zf[8]; unpack8(zr[h][j], zf);
                    const float msk = (pp >= 0 && pp < c.SL) ? 1.f : 0.f;
#pragma unroll
                    for (int e = 0; e < 8; ++e) x[e] += w[j][e >> 2][e & 3] * (zf[e] * msk);
                }
                *(LAS f32x4*)(lds + RG_XF + (rr * 64 + c8 * 8) * 4) = (f32x4){x[0], x[1], x[2], x[3]};
                *(LAS f32x4*)(lds + RG_XF + (rr * 64 + c8 * 8 + 4) * 4) = (f32x4){x[4], x[5], x[6], x[7]};
                *(LAS u32x4*)(lds + RG_XB + rr * 144 + c8 * 16) = pack8(x);
            }
        }
        u32x4 gpre[2] = {{0u, 0u, 0u, 0u}, {0u, 0u, 0u, 0u}};
        if (MODE == 1) { const int tok = tid >> 2, cs = (tid & 3) * 16;
#pragma unroll
            for (int h = 0; h < 2; ++h) gpre[h] = *(const u32x4*)(c.Z + (size_t)(t0 + tok) * LDZ + ZC_RG + n * 64 + cs + 8 * h); }
        { const int un = (u + ustride < NU) ? u + ustride : u; RG_LOAD(un); }
        WG_BARRIER();
        if (wave < 4) rg_wave<MODE, 0>(lds, c, tile, n, wave & 3, lane); else rg_wave<MODE, 1>(lds, c, tile, n, wave & 3, lane);
        WG_BARRIER();
        if (MODE == 1) {
            const int tok = tid >> 2, cs = (tid & 3) * 16;
            const LAS float* hf = (const LAS float*)(lds + RG_HF) + tok * 64 + cs; const LAS float* hb = (const LAS float*)(lds + RG_HB) + tok * 64 + cs;
#pragma unroll
            for (int h = 0; h < 2; ++h) {
                float gt[8]; unpack8(gpre[h], gt);
#pragma unroll
                for (int e = 0; e < 8; ++e) gt[e] = gelu_tanh(gt[e]);
                const f32x4 f0 = *(const LAS f32x4*)(hf + 8 * h), f1 = *(const LAS f32x4*)(hf + 8 * h + 4), b0 = *(const LAS f32x4*)(hb + 8 * h), b1 = *(const LAS f32x4*)(hb + 8 * h + 4);
                float o[8] = {gt[0] * (f0[0] + b0[0]), gt[1] * (f0[1] + b0[1]), gt[2] * (f0[2] + b0[2]), gt[3] * (f0[3] + b0[3]),
                              gt[4] * (f1[0] + b1[0]), gt[5] * (f1[1] + b1[1]), gt[6] * (f1[2] + b1[2]), gt[7] * (f1[3] + b1[3])};
                *(u32x4*)(c.HA + (size_t)(t0 + tok) * DRNN + n * 64 + cs + 8 * h) = pack8(o);
            }
        }
    }
#undef RG_LOAD
#undef RG_WLOAD
}

constexpr int GL_QD = 0, GL_KD = 17408, GL_KET = 34816, GL_VT = 53248, GL_ATT = 62464, GL_ST = 71680, GL_GCS = 89088  , GL_GS = 122880, GL_DEC = 123392, GL_ZGS = 123904;
constexpr int GCS_LD = 132;
struct GlaCtx { const bf16_t* Z; const float* wg2; const float* bg; bf16_t* OF; bf16_t* OK; bf16_t* QDG; bf16_t* KDG; bf16_t* KETG; float* DECG; bf16_t* ATTG; int SL; };
constexpr int NCKG = TG / 64;
template <int DIR>
__device__ __forceinline__ void gla_pre(LAS unsigned char* lds, const GlaCtx& c, int ck, int h, int tid) {
    const int wave = __builtin_amdgcn_readfirstlane(tid >> 6), lane = tid & 63, fr = lane & 15, fq = lane >> 4;
    const int ct_ = tid >> 3, sub = tid & 7;
    bf16x8 wgB;
    {
        float wv[8];
#pragma unroll
        for (int i = 0; i < 8; ++i) wv[i] = (fq < 2) ? c.wg2[((size_t)DIR * 16 + 8 * fq + i) * 512 + h * 128 + 16 * wave + fr] : 0.f;
        const u32x4 wp = pack8(wv); wgB = __builtin_bit_cast(bf16x8, wp);
    }
    const float bgd = c.bg[DIR * 512 + h * 128 + 16 * wave + fr];
    const size_t row0 = (size_t)ck * 64;
    const bf16_t* zr = c.Z + (row0 + ct_) * LDZ;
    u32x4 qraw[2], kraw[2];
    qraw[0] = *(const u32x4*)(zr + ZC_Q + h * 128 + sub * 16); qraw[1] = *(const u32x4*)(zr + ZC_Q + h * 128 + sub * 16 + 8);
    kraw[0] = *(const u32x4*)(zr + ZC_K + h * 128 + sub * 16); kraw[1] = *(const u32x4*)(zr + ZC_K + h * 128 + sub * 16 + 8);
    if (tid < 128) *(LAS u32x4*)(lds + GL_ZGS + (tid >> 1) * 32 + (tid & 1) * 16) = *(const u32x4*)(c.Z + (row0 + (tid >> 1)) * LDZ + ZC_GF + DIR * 16 + (tid & 1) * 8);
    WG_BARRIER();
    {
        LAS float* gcs = (LAS float*)(lds + GL_GCS);
        float carry = 0.f;
#pragma unroll
        for (int tti = 0; tti < 4; ++tti) {
            const int tt = DIR ? 3 - tti : tti;
            bf16x8 Az = {0, 0, 0, 0, 0, 0, 0, 0};
            if (fq < 2) Az = *(const LAS bf16x8*)(lds + GL_ZGS + (16 * tt + fr) * 32 + fq * 16);
            f32x4 lg4 = {0.f, 0.f, 0.f, 0.f};
            lg4 = __builtin_amdgcn_mfma_f32_16x16x32_bf16(Az, wgB, lg4, 0, 0, 0);
            float gv[4];
#pragma unroll
            for (int j = 0; j < 4; ++j) {
                const float lg = lg4[j] + bgd;
                float ls = -__logf(1.f + __expf(-fmaxf(lg, -60.f)));
                if (lg < -60.f) ls = lg;
                gv[j] = ls * 0.0625f;
            }
            float pj[4];
            if (DIR == 0) { pj[0] = gv[0]; pj[1] = pj[0] + gv[1]; pj[2] = pj[1] + gv[2]; pj[3] = pj[2] + gv[3]; }
            else { pj[3] = gv[3]; pj[2] = pj[3] + gv[2]; pj[1] = pj[2] + gv[1]; pj[0] = pj[1] + gv[0]; }
            const float T = DIR ? pj[0] : pj[3];
            const float T0 = __shfl(T, fr), T1 = __shfl(T, fr + 16), T2 = __shfl(T, fr + 32), T3 = __shfl(T, fr + 48);
            float excl = 0.f;
            if (DIR == 0) { if (fq > 0) excl += T0; if (fq > 1) excl += T1; if (fq > 2) excl += T2; }
            else { if (fq < 3) excl += T3; if (fq < 2) excl += T2; if (fq < 1) excl += T1; }
            const float base = carry + excl;
#pragma unroll
            for (int j = 0; j < 4; ++j) gcs[(16 * tt + 4 * fq + j) * GCS_LD + 16 * wave + fr] = base + pj[j];
            carry += (T0 + T1) + (T2 + T3);
        }
        if (fq == 0) ((LAS float*)(lds + GL_GS))[16 * wave + fr] = carry;
    }
    WG_BARRIER();
    {
        const LAS float* gs = (const LAS float*)(lds + GL_GS) + sub * 16;
        const LAS float* gcs = (const LAS float*)(lds + GL_GCS) + ct_ * GCS_LD + sub * 16;
        float qf[16], kf[16];
        { float t8[8]; unpack8(qraw[0], t8);
#pragma unroll
          for (int e = 0; e < 8; ++e) qf[e] = t8[e];
          unpack8(qraw[1], t8);
#pragma unroll
          for (int e = 0; e < 8; ++e) qf[8 + e] = t8[e];
          unpack8(kraw[0], t8);
#pragma unroll
          for (int e = 0; e < 8; ++e) kf[e] = t8[e];
          unpack8(kraw[1], t8);
#pragma unroll
          for (int e = 0; e < 8; ++e) kf[8 + e] = t8[e]; }
        float qd[16], kd[16];
        LAS bf16_t* ket = (LAS bf16_t*)(lds + GL_KET);
        float* decg = c.DECG + (((size_t)DIR * NCKG + ck) * 4 + h) * 128;
#pragma unroll
        for (int e4 = 0; e4 < 4; ++e4) {
            const f32x4 tt4 = *(const LAS f32x4*)(gs + 4 * e4);
            const f32x4 gl = *(const LAS f32x4*)(gcs + 4 * e4);
            if (ct_ == 0) *(f32x4*)(decg + sub * 16 + 4 * e4) = (f32x4){__expf(tt4[0]), __expf(tt4[1]), __expf(tt4[2]), __expf(tt4[3])};
#pragma unroll
            for (int e1 = 0; e1 < 4; ++e1) {
                const int e = 4 * e4 + e1;
                const float tot = tt4[e1], gc = gl[e1];
                const float eq = __expf(gc), ek = __expf(-gc), ee = __expf(tot - gc);
                qd[e] = qf[e] * eq; kd[e] = kf[e] * ek;
                ket[(sub * 16 + e) * 72 + (ct_ ^ (8 * sub))] = f2bf(kf[e] * ee);
            }
        }
        bf16_t* qg = c.QDG + ((size_t)DIR * TG + row0 + ct_) * 512 + h * 128 + sub * 16;
        bf16_t* kg = c.KDG + ((size_t)DIR * TG + row0 + ct_) * 512 + h * 128 + sub * 16;
        float t8[8];
#pragma unroll
        for (int hh = 0; hh < 2; ++hh) {
#pragma unroll
            for (int e = 0; e < 8; ++e) t8[e] = qd[8 * hh + e];
            { const u32x4 w = pack8(t8); *(u32x4*)(qg + 8 * hh) = w; *(LAS u32x4*)(lds + GL_QD + ct_ * 272 + sub * 32 + hh * 16) = w; }
#pragma unroll
            for (int e = 0; e < 8; ++e) t8[e] = kd[8 * hh + e];
            *(LAS u32x4*)(lds + GL_KD + ct_ * 272 + sub * 32 + hh * 16) = pack8(t8);
        }
    }
    WG_BARRIER();
    {
        const int d = tid >> 2, part = tid & 3;
        const u32x4 r0 = *(const LAS u32x4*)(lds + GL_KET + d * 144 + part * 32), r1 = *(const LAS u32x4*)(lds + GL_KET + d * 144 + part * 32 + 16);
        bf16_t* kt = c.KETG + ((((size_t)DIR * NCKG + ck) * 4 + h) * 128 + d) * 64 + part * 16;
        *(u32x4*)kt = r0; *(u32x4*)(kt + 8) = r1;
    }
    {
        const int ctile = wave >> 1;
        bf16x8 Aq[4];
#pragma unroll
        for (int ks = 0; ks < 4; ++ks) Aq[ks] = *(const LAS bf16x8*)(lds + GL_QD + (16 * ctile + fr) * 272 + ks * 64 + fq * 16);
#pragma unroll
        for (int s2 = 0; s2 < 2; ++s2) {
            const int st = 2 * (wave & 1) + s2;
            f32x4 acc = {0.f, 0.f, 0.f, 0.f};
#pragma unroll
            for (int ks = 0; ks < 4; ++ks) { const bf16x8 Bk = *(const LAS bf16x8*)(lds + GL_KD + (16 * st + fr) * 272 + ks * 64 + fq * 16);
                acc = __builtin_amdgcn_mfma_f32_16x16x32_bf16(Aq[ks], Bk, acc, 0, 0, 0); }
            LAS bf16_t* att = (LAS bf16_t*)(lds + GL_ATT);
#pragma unroll
            for (int j = 0; j < 4; ++j) { const int cc = 16 * ctile + 4 * fq + j, ss = 16 * st + fr;
                const bool keep = DIR ? (cc <= ss) : (cc >= ss);
                att[cc * 72 + ss] = f2bf(keep ? acc[j] : 0.f); }
        }
    }
    WG_BARRIER();
    {
        const int r = tid >> 3, part = tid & 7;
        *(u32x4*)(c.ATTG + ((((size_t)DIR * NCKG + ck) * 4 + h) * 64 + r) * 64 + part * 8) = *(const LAS u32x4*)(lds + GL_ATT + r * 144 + part * 16);
    }
    WG_BARRIER();
}

constexpr int SQ_QD = 0, SQ_KET = 17408, SQ_ATT = 35840, SQ_VT = 45056, SQ_ST = 54272, SQ_DEC = 71680, SQ_BUF = 72192;
static_assert(2 * SQ_BUF <= LDS_BYTES - 64, "GLA sequential LDS images");
template <int DIR>
__device__ __forceinline__ void gla_seq(LAS unsigned char* lds, const GlaCtx& c, int seq, int h, int sl, int tid) {
    const int wave = __builtin_amdgcn_readfirstlane(tid >> 6), lane = tid & 63, fr = lane & 15, fq = lane >> 4;
    const int NC = c.SL / 64;
    const int ct_ = tid >> 3, sub = tid & 7;
    bf16_t* Odst = DIR ? c.OK : c.OF;
    f32x4 S[4];
#pragma unroll
    for (int i = 0; i < 4; ++i) S[i] = (f32x4){0.f, 0.f, 0.f, 0.f};
    u32x4 qdr[2][2], ker[2][2], atr[2], vraw[2]; f32x4 decr[2];
#define GLA_ISSUE(chunk_, set_) do { \
        const size_t row_ = (size_t)seq * c.SL + (size_t)(chunk_) * 64; \
        const size_t ckh_ = (((size_t)DIR * NCKG + (row_ >> 6)) * 4 + h); \
        const bf16_t* qg_ = c.QDG + ((size_t)DIR * TG + row_ + ct_) * 512 + h * 128 + sub * 16; \
        qdr[set_][0] = *(const u32x4*)qg_; qdr[set_][1] = *(const u32x4*)(qg_ + 8); \
        const bf16_t* kt_ = c.KETG + (ckh_ * 128 + (tid >> 2)) * 64 + (tid & 3) * 16; \
        ker[set_][0] = *(const u32x4*)kt_; ker[set_][1] = *(const u32x4*)(kt_ + 8); \
        atr[set_] = *(const u32x4*)(c.ATTG + (ckh_ * 64 + ct_) * 64 + sub * 8); \
        vraw[set_] = *(const u32x4*)(c.Z + (row_ + ct_) * LDZ + ZC_V + h * 256 + sl * 64 + sub * 8); \
        decr[set_] = *(const f32x4*)(c.DECG + ckh_ * 128 + (tid & 31) * 4); } while (0)
#define GLA_STAGE(set_, img_) do { \
        LAS unsigned char* B_ = lds + (img_) * SQ_BUF; \
        *(LAS u32x4*)(B_ + SQ_QD + ct_ * 272 + sub * 32) = qdr[set_][0]; *(LAS u32x4*)(B_ + SQ_QD + ct_ * 272 + sub * 32 + 16) = qdr[set_][1]; \
        *(LAS u32x4*)(B_ + SQ_KET + (tid >> 2) * 144 + (tid & 3) * 32) = ker[set_][0]; *(LAS u32x4*)(B_ + SQ_KET + (tid >> 2) * 144 + (tid & 3) * 32 + 16) = ker[set_][1]; \
        *(LAS u32x4*)(B_ + SQ_ATT + ct_ * 144 + sub * 16) = atr[set_]; \
        if (tid < 32) *(LAS f32x4*)(B_ + SQ_DEC + tid * 16) = decr[set_]; \
        { LAS bf16_t* vt_ = (LAS bf16_t*)(B_ + SQ_VT); const unsigned vw_[4] = {vraw[set_].x, vraw[set_].y, vraw[set_].z, vraw[set_].w}; \
          _Pragma("unroll") for (int e = 0; e < 4; ++e) { vt_[(sub * 8 + 2 * e) * 72 + (ct_ ^ (8 * sub))] = (bf16_t)(vw_[e] & 0xffffu); vt_[(sub * 8 + 2 * e + 1) * 72 + (ct_ ^ (8 * sub))] = (bf16_t)(vw_[e] >> 16); } } \
        _Pragma("unroll") for (int dt = 0; dt < 4; ++dt) { u32x2 w_; w_.x = cvt_pk_bf16(S[dt][0], S[dt][1]); w_.y = cvt_pk_bf16(S[dt][2], S[dt][3]); \
            *(LAS u32x2*)(B_ + SQ_ST + (16 * dt + fr) * 272 + (16 * wave + 4 * fq) * 2) = w_; } } while (0)
    GLA_ISSUE(DIR ? NC - 1 : 0, 0);
    GLA_ISSUE(DIR ? NC - 2 : 1, 1);
    GLA_STAGE(0, 0);
    GLA_ISSUE(DIR ? NC - 3 : 2, 0);
    WG_BARRIER();
#pragma unroll 1
    for (int ci2 = 0; ci2 < NC; ci2 += 2) {
#pragma unroll
      for (int ph = 0; ph < 2; ++ph) {
        const int ci = ci2 + ph;
        const int chunk = DIR ? NC - 1 - ci : ci;
        LAS unsigned char* B = lds + ph * SQ_BUF;
        {
            const int ctile = wave >> 1;
            const size_t row0 = (size_t)seq * c.SL + (size_t)chunk * 64;
            bf16x8 Aa[2], Aq[4], Bv[4][2];
#pragma unroll
            for (int dt = 0; dt < 4; ++dt)
#pragma unroll
                for (int ks = 0; ks < 2; ++ks) Bv[dt][ks] = *(const LAS bf16x8*)(B + SQ_VT + (16 * dt + fr) * 144 + (((32 * ks + 8 * fq) ^ (8 * ((2 * dt + (fr >> 3)) & 7))) * 2));
#pragma unroll
            for (int ks = 0; ks < 2; ++ks) Aa[ks] = *(const LAS bf16x8*)(B + SQ_ATT + (16 * ctile + fr) * 144 + ks * 64 + fq * 16);
#pragma unroll
            for (int ks = 0; ks < 4; ++ks) Aq[ks] = *(const LAS bf16x8*)(B + SQ_QD + (16 * ctile + fr) * 272 + ks * 64 + fq * 16);
#define GLA_OTILE(dt_) do { \
                f32x4 acc = {0.f, 0.f, 0.f, 0.f}; \
                  \
                _Pragma("unroll") for (int ks = 0; ks < 2; ++ks) acc = __builtin_amdgcn_mfma_f32_16x16x32_bf16(Bv[dt_][ks], Aa[ks], acc, 0, 0, 0); \
                _Pragma("unroll") for (int ks = 0; ks < 4; ++ks) { const bf16x8 Bs = *(const LAS bf16x8*)(B + SQ_ST + (16 * (dt_) + fr) * 272 + ks * 64 + fq * 16); \
                    acc = __builtin_amdgcn_mfma_f32_16x16x32_bf16(Bs, Aq[ks], acc, 0, 0, 0); } \
                { u32x2 w_; w_.x = cvt_pk_bf16(acc[0], acc[1]); w_.y = cvt_pk_bf16(acc[2], acc[3]); \
                  *(u32x2*)(Odst + (row0 + 16 * ctile + fr) * DRNN + h * 256 + sl * 64 + 16 * (dt_) + 4 * fq) = w_; } } while (0)
            if (wave & 1) { GLA_OTILE(2); GLA_OTILE(3); } else { GLA_OTILE(0); GLA_OTILE(1); }
#undef GLA_OTILE
            const f32x4 dec = *(const LAS f32x4*)(B + SQ_DEC + (16 * wave + 4 * fq) * 4);
            bf16x8 Ak[2];
#pragma unroll
            for (int ks = 0; ks < 2; ++ks) Ak[ks] = *(const LAS bf16x8*)(B + SQ_KET + (16 * wave + fr) * 144 + (((32 * ks + 8 * fq) ^ (8 * wave)) * 2));
#pragma unroll
            for (int dt = 0; dt < 4; ++dt) {
                S[dt] = S[dt] * dec;
#pragma unroll
                for (int ks = 0; ks < 2; ++ks) S[dt] = __builtin_amdgcn_mfma_f32_16x16x32_bf16(Ak[ks], Bv[dt][ks], S[dt], 0, 0, 0);
            }
        }
        GLA_STAGE(ph ^ 1, ph ^ 1);
        { const int cn = DIR ? (NC - 4 - ci > 0 ? NC - 4 - ci : 0) : (ci + 3 < NC - 1 ? ci + 3 : NC - 1); GLA_ISSUE(cn, ph ^ 1); }
        WG_BARRIER();
      }
    }
#undef GLA_ISSUE
#undef GLA_STAGE
}

__device__ __forceinline__ void gla_finalize(const bf16_t* Z, const bf16_t* OF, const bf16_t* OK, const float* nw, bf16_t* OB, int G, int b, int tid) {
    const int l32 = tid & 31, pr = tid >> 5;
    const f32x4 w0 = *(const f32x4*)(nw + l32 * 8), w1 = *(const f32x4*)(nw + l32 * 8 + 4);
    constexpr int NIT = TG * 4 / 16, FB = 4;
    for (int it0 = b; it0 < NIT; it0 += FB * G) {
        u32x4 ra[FB], rb[FB], rg[FB];
#pragma unroll
        for (int k = 0; k < FB; ++k) { const int it = it0 + k * G; if (it < NIT) {
            const int pair = it * 16 + pr, t = pair >> 2, hd = pair & 3; const size_t o = (size_t)t * DRNN + hd * 256 + l32 * 8;
            ra[k] = *(const u32x4*)(OF + o); rb[k] = *(const u32x4*)(OK + o); rg[k] = *(const u32x4*)(Z + (size_t)t * LDZ + ZC_OG + hd * 256 + l32 * 8); } }
#pragma unroll
        for (int k = 0; k < FB; ++k) { const int it = it0 + k * G; if (it < NIT) {
            const int pair = it * 16 + pr, t = pair >> 2, hd = pair & 3; const size_t o = (size_t)t * DRNN + hd * 256 + l32 * 8;
            float a[8], bb[8], gq[8];
            unpack8(ra[k], a); unpack8(rb[k], bb); unpack8(rg[k], gq);
            float ss = 0.f;
#pragma unroll
            for (int e = 0; e < 8; ++e) { a[e] += bb[e]; ss += a[e] * a[e]; gq[e] = gq[e] * sigmoid_f(gq[e]); }
#pragma unroll
            for (int off = 1; off < 32; off <<= 1) ss += __shfl_xor(ss, off);
            const float rs = 1.f / sqrtf(ss * (1.f / 256.f) + EPS);
            float r[8] = {a[0] * rs * w0[0] * gq[0], a[1] * rs * w0[1] * gq[1], a[2] * rs * w0[2] * gq[2], a[3] * rs * w0[3] * gq[3],
                          a[4] * rs * w1[0] * gq[4], a[5] * rs * w1[1] * gq[5], a[6] * rs * w1[2] * gq[6], a[7] * rs * w1[3] * gq[7]};
            *(u32x4*)(OB + o) = pack8(r); } }
    }
}

__device__ __forceinline__ void ff_elem(const bf16_t* U, const float* cw, const float* cb, bf16_t* HDN, int SL, int G, int b, int tid) {
    const int NIT = (TG / 32) * (DFF / 8);
    for (int it = b * 512 + tid; it < NIT; it += G * 512) {
        const int rb = it / (DFF / 8), cgp = it % (DFF / 8), r0 = rb * 32, c0 = cgp * 8;
        float w0[8], w1[8], w2[8], bb[8];
#pragma unroll
        for (int e = 0; e < 8; ++e) { w0[e] = cw[c0 + e]; w1[e] = cw[DFF + c0 + e]; w2[e] = cw[2 * DFF + c0 + e]; bb[e] = cb[c0 + e]; }
        float pv[8], cv[8], nv[8];
        if ((r0 & (SL - 1)) == 0) {
#pragma unroll
            for (int e = 0; e < 8; ++e) pv[e] = 0.f;
        } else unpack8(*(const u32x4*)(U + (size_t)(r0 - 1) * (2 * DFF) + c0), pv);
        unpack8(*(const u32x4*)(U + (size_t)r0 * (2 * DFF) + c0), cv);
        u32x4 gq[2][8], vq[2][8];
#define FF_LOAD(sb_, set_) do { _Pragma("unroll") for (int k = 0; k < 8; ++k) { const int r_ = r0 + (sb_) * 8 + k; \
            gq[set_][k] = __builtin_nontemporal_load((const u32x4*)(U + (size_t)(r_ + 1) * (2 * DFF) + c0)); \
            vq[set_][k] = __builtin_nontemporal_load((const u32x4*)(U + (size_t)r_ * (2 * DFF) + DFF + c0)); } } while (0)
#define FF_DO(sb_, set_) do { _Pragma("unroll") for (int k = 0; k < 8; ++k) { const int r = r0 + (sb_) * 8 + k; \
            unpack8(gq[set_][k], nv); \
            if (((r + 1) & (SL - 1)) == 0) { _Pragma("unroll") for (int e = 0; e < 8; ++e) nv[e] = 0.f; } \
            float uv[8]; unpack8(vq[set_][k], uv); float o[8]; \
            _Pragma("unroll") for (int e = 0; e < 8; ++e) { const float pre = bb[e] + w0[e] * pv[e] + w1[e] * cv[e] + w2[e] * nv[e]; o[e] = gelu_tanh(pre) * uv[e]; pv[e] = cv[e]; cv[e] = nv[e]; } \
            *(u32x4*)(HDN + (size_t)r * DFF + c0) = pack8(o); } } while (0)
        FF_LOAD(0, 0);
        FF_LOAD(1, 1); FF_DO(0, 0);
        FF_LOAD(2, 0); FF_DO(1, 1);
        FF_LOAD(3, 1); FF_DO(2, 0);
        FF_DO(3, 1);
#undef FF_LOAD
#undef FF_DO
    }
}

typedef const __attribute__((address_space(4))) Args* KArgs;
#define AIN(i) ((const float*)ap->in[i])
__global__ void __launch_bounds__(512, 2) mega_fwd(Args a_byval) {
    extern __shared__ __attribute__((aligned(16))) unsigned char lds_raw[];
    LAS unsigned char* lds = (LAS unsigned char*)lds_raw;
    int p, hi;
    { KArgs ap0 = (KArgs)__builtin_amdgcn_kernarg_segment_ptr(); p = ap0->ph_lo; hi = ap0->ph_hi;
      if (threadIdx.x == 0) { ((volatile LAS unsigned*)(lds + LDS_MISC))[0] = 0u; ((volatile LAS unsigned*)(lds + LDS_MISC))[1] = 0u;
          if (hi - p > 1) (void)xb_add((unsigned*)(ap0->ws + WS_CTL) + XB_XCNT(xb_xcc_id()), 1u); }
      __syncthreads(); }
    for (; p < hi; ++p) {
        int nrep = 1;
        if (REPMASK) { const int rr = (p == 0) ? 10 : (((p - 1) % PH_PER_GROUP == 0) ? 11 : (((p - 1) % PH_PER_GROUP - 1) % PH_PER_LAYER)); if ((REPMASK >> rr) & 1) nrep = 2; }
        for (int rep = 0; rep < nrep; ++rep) {
        KArgs ap = (KArgs)__builtin_amdgcn_kernarg_segment_ptr();
        asm volatile("" : "+s"(ap) :: "memory");
        int tid = threadIdx.x, b = blockIdx.x, G = gridDim.x;
        asm volatile("" : "+v"(tid), "+s"(b), "+s"(G));
        const int wave = __builtin_amdgcn_readfirstlane(tid >> 6), lane = tid & 63;
        unsigned char* ws = ap->ws;
        if (p == 0) { {
            Args a;
            a.in[I_WIN] = AIN(I_WIN); a.in[I_WUP] = AIN(I_WUP); a.in[I_WDN] = AIN(I_WDN); a.in[I_WOUT] = AIN(I_WOUT); a.in[I_WPA] = AIN(I_WPA); a.in[I_WPB] = AIN(I_WPB);
            a.in[I_BIN] = AIN(I_BIN); a.in[I_RWA] = AIN(I_RWA); a.in[I_RWX] = AIN(I_RWX); a.ws = ws;
            phase_convert(a, lds, G, b, tid); }
        } else {
            const int q = p - 1, g = q / PH_PER_GROUP, r = q % PH_PER_GROUP;
            float* X = ap->out + (size_t)g * TG * D;
            const int SL = (g == 0) ? 8192 : 2048;
            bf16_t* XN = (bf16_t*)(ws + WS_XN);
            if (r == 0) { {
                const float* src = (g == 0) ? AIN(I_XP) : AIN(I_XS) + (size_t)(g - 1) * TG * D;
                const float* gam = AIN(I_LNIG); const float* bet = AIN(I_LNIB);
                for (int m = b * 8 + wave; m < TG / LNR; m += G * 8) ln_rows<LNR>(src + (size_t)m * D, X + (size_t)m * D, XN + (size_t)m * D, nullptr, TG / LNR, gam, bet, lane); }
            } else {
                const int l = (r - 1) / PH_PER_LAYER, s = (r - 1) % PH_PER_LAYER;
                unsigned char* lw = ws + (size_t)l * LW_SIZE;
                bf16_t* Z = (bf16_t*)(ws + WS_Z);
                switch (s) {
                case 0: {
                    pg8::Gemm gm{XN, D, (const bf16_t*)(lw + LW_WIN), TG, NZ, D}; pg8::StaticOrder S; S.init(TG, NZ, G, b, WGM_BIG);
                    pg8::EpiZ E{Z, (const float*)(lw + LW_BIAS)};
                    pg8::gemm_phase(lds, gm, S, E, tid);
                } break;
                case 1: {
                    {
                        GlaCtx gc{Z, AIN(I_WG2) + (size_t)l * 2 * 16 * 512, AIN(I_BG) + (size_t)l * 2 * 512, (bf16_t*)(ws + WS_OF), (bf16_t*)(ws + WS_OK),
                                  (bf16_t*)(ws + WS_QDG), (bf16_t*)(ws + WS_KDG), (bf16_t*)(ws + WS_KETG), (float*)(ws + WS_DECG), (bf16_t*)(ws + WS_ATTG), SL};
                        for (int u = b; u < NCKG * 8; u += G) {
                            const int dir = (u >> 3) & 1, h = (u >> 1) & 3, ck = (u & 1) | ((u >> 4) << 1);
                            if (dir) gla_pre<1>(lds, gc, ck, h, tid); else gla_pre<0>(lds, gc, ck, h, tid);
                        }
                    }
                    RgCtx rc{Z, AIN(I_CRW) + (size_t)l * 4 * DRNN, AIN(I_CRB) + (size_t)l * DRNN, (const bf16_t*)(lw + LW_RGW), AIN(I_RBA) + (size_t)l * 2 * DRNN,
                             AIN(I_RBX) + (size_t)l * 2 * DRNN, AIN(I_LAM) + (size_t)l * 2 * DRNN, (float*)(ws + WS_CARRY), (bf16_t*)(ws + WS_HA), SL};
                    rg_phase<0>(lds, rc, b, G, tid);
                } break;
                case 2: {
                    const int nseq = TG / SL, ngla = nseq * 32;
                    {
                        GlaCtx gc{Z, AIN(I_WG2) + (size_t)l * 2 * 16 * 512, AIN(I_BG) + (size_t)l * 2 * 512, (bf16_t*)(ws + WS_OF), (bf16_t*)(ws + WS_OK),
                                  (bf16_t*)(ws + WS_QDG), (bf16_t*)(ws + WS_KDG), (bf16_t*)(ws + WS_KETG), (float*)(ws + WS_DECG), (bf16_t*)(ws + WS_ATTG), SL};
                        for (int u = b; u < ngla; u += G) {
                            const int sl = (u >> 3) & 3, idx = (u & 7) | ((u >> 5) << 3), dir = idx & 1, h = (idx >> 1) & 3, seq = idx >> 3;
                            if (dir) gla_seq<1>(lds, gc, seq, h, sl, tid); else gla_seq<0>(lds, gc, seq, h, sl, tid);
                        }
                    }
                    RgCtx rc{Z, AIN(I_CRW) + (size_t)l * 4 * DRNN, AIN(I_CRB) + (size_t)l * DRNN, (const bf16_t*)(lw + LW_RGW), AIN(I_RBA) + (size_t)l * 2 * DRNN,
                             AIN(I_RBX) + (size_t)l * 2 * DRNN, AIN(I_LAM) + (size_t)l * 2 * DRNN, (float*)(ws + WS_CARRY), (bf16_t*)(ws + WS_HA), SL};
                    int w0 = 0, nw = G;
                    if (ngla <= G / 2) { w0 = ngla; nw = G - ngla; }
                    if (b >= w0) rg_phase<1>(lds, rc, b - w0, nw, tid);
                } break;
                case 3: {
                    gla_finalize(Z, (const bf16_t*)(ws + WS_OF), (const bf16_t*)(ws + WS_OK), AIN(I_NW) + (size_t)l * 256, (bf16_t*)(ws + WS_OB), G, b, tid);
                } break;
                case 4: {
                    { pg8::Gemm gm{(const bf16_t*)(ws + WS_HA), DRNN, (const bf16_t*)(lw + LW_WPA), TG, D, DRNN}; pg8::StaticOrder S; S.init(TG, D, G, b, WGM_SMALL);
                      pg8::EpiGate<false> E{Z + ZC_MA, Z + ZC_MA, nullptr}; pg8::gemm_phase(lds, gm, S, E, tid); }
                    { pg8::Gemm gm{(const bf16_t*)(ws + WS_OB), DRNN, (const bf16_t*)(lw + LW_WPB), TG, D, DRNN}; pg8::StaticOrder S; S.init(TG, D, G, b, WGM_SMALL);
                      pg8::EpiGate<true> E{Z + ZC_MA, Z + ZC_MB, Z + ZC_MA}; pg8::gemm_phase(lds, gm, S, E, tid); }
                } break;
                case 5: {
                    pg8::Gemm gm{Z + ZC_MA, LDZ, (const bf16_t*)(lw + LW_WOUT), TG, D, D}; pg8::StaticOrder S; S.init(TG, D, G, b, WGM_SMALL);
                    if (l == 0) { pg8::EpiRes<false> E{X, nullptr, nullptr, nullptr, REPMASK && rep + 1 < nrep}; pg8::gemm_phase(lds, gm, S, E, tid); }
                    else { pg8::EpiRes<true> E{X, (const float*)(ws + WS_STATS), AIN(I_LFG) + (size_t)(l - 1) * D, AIN(I_LFB) + (size_t)(l - 1) * D, REPMASK && rep + 1 < nrep}; pg8::gemm_phase(lds, gm, S, E, tid); }
                } break;
                case 6: {
                    const float* gam = AIN(I_LMG) + (size_t)l * D; const float* bet = AIN(I_LMB) + (size_t)l * D;
                    for (int m = b * 8 + wave; m < TG / LNR; m += G * 8) ln_rows<LNR>(X + (size_t)m * D, nullptr, XN + (size_t)m * D, (float*)(ws + WS_STATS) + 2 * m, TG / LNR, gam, bet, lane);
                } break;
                case 7: {
                    pg8::Gemm gm{XN, D, (const bf16_t*)(lw + LW_WUP), TG, 2 * DFF, D}; pg8::StaticOrder S; S.init(TG, 2 * DFF, G, b, WGM_BIG);
                    pg8::EpiBf16 E{(bf16_t*)(ws + WS_U), 2 * DFF}; pg8::gemm_phase(lds, gm, S, E, tid);
                } break;
                case 8: {
                    ff_elem((const bf16_t*)(ws + WS_U), AIN(I_CFW) + (size_t)l * 3 * DFF, AIN(I_CFB) + (size_t)l * DFF, (bf16_t*)(ws + WS_HDN), SL, G, b, tid);
                } break;
                case 9: {
                    pg8::Gemm gm{(const bf16_t*)(ws + WS_HDN), DFF, (const bf16_t*)(lw + LW_WDN), TG, D, DFF}; pg8::StaticOrder S; S.init(TG, D, G, b, WGM_SMALL);
                    pg8::EpiRes<true> E{X, (const float*)(ws + WS_STATS), AIN(I_LMG) + (size_t)l * D, AIN(I_LMB) + (size_t)l * D, REPMASK && rep + 1 < nrep}; pg8::gemm_phase(lds, gm, S, E, tid);
                } break;
                default: {
                    const float* gam = AIN(I_LFG) + (size_t)l * D; const float* bet = AIN(I_LFB) + (size_t)l * D;
                    for (int m = b * 8 + wave; m < TG / LNR; m += G * 8) { const bool lastl = (l + 1 >= DEPTH);
                        ln_rows<LNR>(X + (size_t)m * D, lastl ? X + (size_t)m * D : nullptr, lastl ? nullptr : XN + (size_t)m * D, (float*)(ws + WS_STATS) + 2 * m, TG / LNR, gam, bet, lane); }
                } break;
                }
            }
        }
        }
        if (p + 1 < hi) {
            if (p == 0) { __syncthreads(); cg::this_grid().sync(); }
            else { KArgs apb = (KArgs)__builtin_amdgcn_kernarg_segment_ptr(); xcd_barrier((unsigned*)(apb->ws + WS_CTL), (volatile LAS unsigned*)(lds + LDS_MISC));
                   if ((REPMASK >> 15) & 1) xcd_barrier((unsigned*)(apb->ws + WS_CTL), (volatile LAS unsigned*)(lds + LDS_MISC)); }
        }
    }
}

extern "C" void kernel_launch(void* const* d_in, const int* in_sizes, int n_in, void* d_out, int out_size, void* d_ws, size_t ws_size, hipStream_t stream) {
    static int grid = 0;
    if (grid == 0) {
        if (n_in != 27 || out_size != TALL * D || ws_size < WS_END) { fprintf(stderr, "kernel_launch: unexpected shapes n_in %d out %d ws %zu (need %zu)\n", n_in, out_size, ws_size, (size_t)WS_END); grid = -1; return; }
        int dev = 0, cus = 0, per_cu = 0;
        hipGetDevice(&dev); hipDeviceGetAttribute(&cus, hipDeviceAttributeMultiprocessorCount, dev);
        if (hipFuncSetAttribute((const void*)mega_fwd, hipFuncAttributeMaxDynamicSharedMemorySize, LDS_BYTES) != hipSuccess) { fprintf(stderr, "hipFuncSetAttribute failed\n"); grid = -1; return; }
        if (hipOccupancyMaxActiveBlocksPerMultiprocessor(&per_cu, (const void*)mega_fwd, 512, LDS_BYTES) != hipSuccess || per_cu < 1) { fprintf(stderr, "occupancy query: %d\n", per_cu); per_cu = 1; }
        (void)hipGetLastError();
        grid = cus * per_cu;
    }
    if (grid < 0) return;
    Args a{};
    for (int i = 0; i < 27; ++i) a.in[i] = (const float*)d_in[i];
    a.out = (float*)d_out; a.ws = (unsigned char*)d_ws;
#if ONE_LAUNCH
    if (hipMemsetAsync((char*)d_ws + WS_CTL, 0, CTL_BYTES, stream) != hipSuccess) { fprintf(stderr, "memset failed\n"); return; }
    a.ph_lo = 0; a.ph_hi = NPH;
    void* args[] = {&a};
    hipError_t e = hipLaunchCooperativeKernel((const void*)mega_fwd, dim3(grid), dim3(512), args, LDS_BYTES, stream);
    if (e != hipSuccess) fprintf(stderr, "cooperative launch failed: %s (grid %d)\n", hipGetErrorString(e), grid);
#else
    for (int p = 0; p < NPH; ++p) {
        a.ph_lo = p; a.ph_hi = p + 1;
        hipLaunchKernelGGL(mega_fwd, dim3(grid), dim3(512), LDS_BYTES, stream, a);
    }
#endif
}
```

```cpp
#include <hip/hip_runtime.h>
#include <hip/hip_cooperative_groups.h>
#include <cstdio>
#include <cstdint>
namespace cg = cooperative_groups;

#ifndef PHMASK
#define PHMASK 0xFFFF
#endif
#define EN(k) (((PHMASK) >> (k)) & 1)
#ifndef WGM_BIG
#define WGM_BIG 6
#endif
#ifndef WGM_SMALL
#define WGM_SMALL 4
#endif
#ifndef LNR
#define LNR 4
#endif
#ifndef REPMASK
#define REPMASK 0
#endif
#ifndef GLA_DBG
#define GLA_DBG 0
#endif
#ifndef ONE_LAUNCH
#define ONE_LAUNCH 1
#endif

#define LAS __attribute__((address_space(3)))
typedef unsigned short bf16_t;
typedef short bf16x8 __attribute__((ext_vector_type(8)));
typedef float f32x4 __attribute__((ext_vector_type(4)));
typedef float f32x2 __attribute__((ext_vector_type(2)));
typedef unsigned u32x4 __attribute__((ext_vector_type(4)));
typedef unsigned u32x2 __attribute__((ext_vector_type(2)));

constexpr int D = 2048, TALL = 49152, NG = 3, TG = 16384, LDZ = 9248, NZ = 9472, DRNN = 1024, DFF = 6144, DEPTH = 2;
constexpr int ZC_RX = 0, ZC_RG = 1024, ZC_Q = 2048, ZC_K = 2560, ZC_V = 3072, ZC_OG = 4096, ZC_MA = 5120, ZC_MB = 7168, ZC_GF = 9216;
constexpr float ALPHA = 1.41421356237f, EPS = 1e-5f;
constexpr int PH_PER_LAYER = 11, PH_PER_GROUP = 1 + DEPTH * PH_PER_LAYER, NPH = 1 + NG * PH_PER_GROUP;

constexpr size_t MiB = 1u << 20;
constexpr size_t WIN_B = (size_t)NZ * D * 2, WUP_B = (size_t)2 * DFF * D * 2, WDN_B = (size_t)D * DFF * 2, WOUT_B = (size_t)D * D * 2, WPA_B = (size_t)D * DRNN * 2;
constexpr size_t RGW_B = (size_t)2 * 2 * 16 * 64 * 64 * 2, BIASP_B = 65536;
constexpr size_t LW_WIN = 0, LW_WUP = LW_WIN + WIN_B, LW_WDN = LW_WUP + WUP_B, LW_WOUT = LW_WDN + WDN_B, LW_WPA = LW_WOUT + WOUT_B, LW_WPB = LW_WPA + WPA_B,
                 LW_RGW = LW_WPB + WPA_B, LW_BIAS = LW_RGW + RGW_B, LW_SIZE = LW_BIAS + BIASP_B;
constexpr size_t WS_XN = DEPTH * LW_SIZE, WS_CARRY = WS_XN + 64 * MiB, WS_R = WS_CARRY + 2 * MiB;
constexpr size_t WS_Z = WS_R, WS_HA = WS_R + 289 * MiB, WS_OB = WS_HA + 32 * MiB, WS_OF = WS_OB + 32 * MiB, WS_OK = WS_OF + 32 * MiB;
constexpr size_t WS_QDG = WS_OK + 32 * MiB, WS_KDG = WS_QDG + 32 * MiB, WS_KETG = WS_KDG + 32 * MiB, WS_DECG = WS_KETG + 32 * MiB, WS_ATTG = WS_DECG + 1 * MiB;
constexpr size_t WS_U = WS_R, WS_HDN = WS_R + 384 * MiB, WS_CTL = WS_R + 576 * MiB, CTL_BYTES = 65536, WS_STATS = WS_CTL + CTL_BYTES  , WS_END = WS_STATS + (size_t)TG * 8;
static_assert((size_t)TG * LDZ * 2 == 289 * MiB, "z size");
static_assert(LW_SIZE % 256 == 0, "align");

constexpr int LDS_BYTES = 147456;

typedef __bf16 bf16x2_t __attribute__((ext_vector_type(2)));
__device__ __forceinline__ unsigned cvt_pk_bf16(float lo, float hi) { f32x2 v = {lo, hi}; bf16x2_t b = __builtin_convertvector(v, bf16x2_t); return __builtin_bit_cast(unsigned, b); }
__device__ __forceinline__ float bflo(unsigned w) { return __uint_as_float(w << 16); }
__device__ __forceinline__ float bfhi(unsigned w) { return __uint_as_float(w & 0xffff0000u); }
__device__ __forceinline__ float bf2f(unsigned short h) { return __uint_as_float((unsigned)h << 16); }
__device__ __forceinline__ unsigned short f2bf(float f) { return (unsigned short)(cvt_pk_bf16(f, 0.f) & 0xffffu); }
__device__ __forceinline__ float sigmoid_f(float x) { return __builtin_amdgcn_rcpf(1.f + __expf(-x)); }
__device__ __forceinline__ float gelu_tanh(float v) { return v * sigmoid_f(1.5957691216f * (v + 0.044715f * v * v * v)); }
__device__ __forceinline__ float wave_sum(float v) {
#pragma unroll
    for (int o = 1; o < 64; o <<= 1) v += __shfl_xor(v, o);
    return v;
}
__device__ __forceinline__ void unpack8(u32x4 w, float (&f)[8]) {
    f[0] = bflo(w.x); f[1] = bfhi(w.x); f[2] = bflo(w.y); f[3] = bfhi(w.y); f[4] = bflo(w.z); f[5] = bfhi(w.z); f[6] = bflo(w.w); f[7] = bfhi(w.w);
}
__device__ __forceinline__ u32x4 pack8(const float (&f)[8]) {
    u32x4 w; w.x = cvt_pk_bf16(f[0], f[1]); w.y = cvt_pk_bf16(f[2], f[3]); w.z = cvt_pk_bf16(f[4], f[5]); w.w = cvt_pk_bf16(f[6], f[7]); return w;
}
#define WG_BARRIER() __syncthreads()

namespace pg8 {
constexpr int BM = 256, BK = 64, HALF = 128, HTB = HALF * BK * 2, STAGE_BYTES = 8 * HTB, NXCD = 8, WGM = 8;
__host__ __device__ __forceinline__ int lds_byte(int r, int c) { const int st = (r >> 4) * 2 + (c >> 5), rr = r & 15, cc = c & 31, ob = rr * 64 + cc * 2; return st * 1024 + (ob ^ (((ob >> 9) & 1) << 5)); }
__host__ __device__ __forceinline__ void stage_rc(int b, int& R, int& C) { const int st = b / 1024, sb = b % 1024, swz = sb ^ (((sb >> 9) & 1) << 5); R = (st >> 1) * 16 + swz / 64; C = (st & 1) * 32 + (swz % 64) / 2; }
__host__ __device__ __forceinline__ int perm32(int rho) { const int n = rho >> 4, i = rho & 15; return 8 * (i >> 2) + 4 * n + (i & 3); }

struct Unit { int pm, pn; };
struct Gemm { const bf16_t* A; int lda; const bf16_t* Bt; int M, N, K; };

struct StaticOrder {
    int nM, nN, nwg, G, c, wgm;
    __device__ void init(int M, int N, int G_, int c_, int wgm_ = WGM) { nM = M / BM; nN = N / BM; nwg = nM * nN; G = G_; c = c_; wgm = wgm_; }
    __device__ bool next(int i, Unit& u) const {
        const long L = (long)i * G + c; if (L >= nwg) return false;
        int wgid = (int)L; { const int q = nwg / NXCD, r = nwg % NXCD, xcd = wgid % NXCD, off = wgid / NXCD; wgid = (xcd < r ? xcd * (q + 1) : r * (q + 1) + (xcd - r) * q) + off; }
        const int nig = wgm * nN, gid = wgid / nig, fm = gid * wgm, gsz = (nM - fm) < wgm ? (nM - fm) : wgm;
        u.pm = fm + ((wgid % nig) % gsz); u.pn = (wgid % nig) / gsz; return true;
    }
};

template <class Epi, class Sched>
__device__ __forceinline__ void gemm_phase(LAS unsigned char* lds, const Gemm g, const Sched& S, const Epi& E, const int tid) {
    const int wid = __builtin_amdgcn_readfirstlane(tid >> 6), lane = tid & 63, wr = wid >> 2, wc = wid & 3, fr = lane & 15, fq = lane >> 4;
    const int K = g.K, nt = K / BK, lda = g.lda;
    unsigned voffA[2], voffB[2];
#pragma unroll
    for (int i = 0; i < 2; ++i) { int R, C; stage_rc(tid * 16 + i * 8192, R, C); const int Rb = Epi::PERM ? ((R & ~31) + perm32(R & 31)) : R;
        voffA[i] = (unsigned)(R * lda + C) * 2u; voffB[i] = (unsigned)(Rb * K + C) * 2u; }
    const size_t kstep = (size_t)(BK * 2);
    const size_t hstepA = (size_t)HALF * lda * 2, hstepB = (size_t)HALF * K * 2;
    const size_t tstepA = 2 * hstepA, tstepB = 2 * hstepB;
    const unsigned ldsw = (unsigned)wid * 1024u;
    const int aoff = lds_byte(wr * 64 + fr, fq * 8), boff = lds_byte(wc * 32 + fr, fq * 8);
#define PG8_SA(b, h) (((b) * 2 + (h)) * HTB)
#define PG8_SB(b, h) ((4 + (b) * 2 + (h)) * HTB)
#define PG8_STAGE(bufoff, gbase, voff) do { _Pragma("unroll") for (int _i = 0; _i < 2; ++_i) \
        __builtin_amdgcn_global_load_lds((const unsigned*)((const char*)(gbase) + (voff)[_i]), (LAS unsigned*)(lds + (bufoff) + ldsw + _i * 8192), 16, 0, 0); } while (0)
#define PG8_LDA(dst, b, h) do { _Pragma("unroll") for (int m = 0; m < 4; ++m) _Pragma("unroll") for (int k = 0; k < 2; ++k) dst[m][k] = *(const LAS bf16x8*)(lds + PG8_SA(b, h) + aoff + m * 2048 + k * 1024); } while (0)
#define PG8_LDB(dst, b, h) do { _Pragma("unroll") for (int n = 0; n < 2; ++n) _Pragma("unroll") for (int k = 0; k < 2; ++k) dst[n][k] = *(const LAS bf16x8*)(lds + PG8_SB(b, h) + boff + n * 2048 + k * 1024); } while (0)
#define PG8_MMA(ai, bj, At, Bt) do { __builtin_amdgcn_s_setprio(1); _Pragma("unroll") for (int m = 0; m < 4; ++m) _Pragma("unroll") for (int n = 0; n < 2; ++n) _Pragma("unroll") for (int k = 0; k < 2; ++k) \
        acc[ai][bj][m][n] = __builtin_amdgcn_mfma_f32_16x16x32_bf16(Bt[n][k], At[m][k], acc[ai][bj][m][n], 0, 0, 0); __builtin_amdgcn_s_setprio(0); } while (0)
#define PG8_WAIT_V(n) asm volatile("s_waitcnt vmcnt(" #n ")" ::: "memory")
#define PG8_WAIT_L(n) asm volatile("s_waitcnt lgkmcnt(" #n ")" ::: "memory")
#define PG8_BAR __builtin_amdgcn_s_barrier()
#define PG8_SCHED __builtin_amdgcn_sched_barrier(0)
    Unit cur, nxt; int ui = 0;
    if (!S.next(0, cur)) return;
    f32x4 acc[2][2][4][2];
#pragma unroll
    for (int a = 0; a < 2; ++a)
#pragma unroll
        for (int b = 0; b < 2; ++b)
#pragma unroll
            for (int m = 0; m < 4; ++m)
#pragma unroll
                for (int n = 0; n < 2; ++n) acc[a][b][m][n] = (f32x4){0.f, 0.f, 0.f, 0.f};
    bf16x8 At[4][2], B0[2][2], B1[2][2];
    const char* cA = (const char*)g.A + (size_t)cur.pm * tstepA; const char* cB = (const char*)g.Bt + (size_t)cur.pn * tstepB;
    PG8_STAGE(PG8_SB(0, 0), cB, voffB); PG8_STAGE(PG8_SB(0, 1), cB + hstepB, voffB); PG8_STAGE(PG8_SA(0, 0), cA, voffA); PG8_STAGE(PG8_SA(0, 1), cA + hstepA, voffA);
    if (wr == 1) PG8_BAR;
    PG8_WAIT_V(2); PG8_BAR;
    PG8_STAGE(PG8_SB(1, 0), cB + kstep, voffB); PG8_STAGE(PG8_SA(1, 0), cA + kstep, voffA); PG8_STAGE(PG8_SB(1, 1), cB + hstepB + kstep, voffB);
    PG8_WAIT_V(6); PG8_BAR;
    for (;;) {
        const bool has_next = S.next(ui + 1, nxt);
        const char* nA = has_next ? (const char*)g.A + (size_t)nxt.pm * tstepA : cA; const char* nB = has_next ? (const char*)g.Bt + (size_t)nxt.pn * tstepB : cB;
        for (int t = 0; t < nt; t += 2) {
            const bool last = (t == nt - 2);
            const char* a1 = cA + (size_t)(t + 1) * kstep;
            const char* a2 = last ? nA : cA + (size_t)(t + 2) * kstep; const char* b2 = last ? nB : cB + (size_t)(t + 2) * kstep;
            const char* a3 = a2 + kstep; const char* b3 = b2 + kstep;
            PG8_LDB(B0, 0, 0); PG8_LDB(B1, 0, 1); PG8_SCHED; PG8_LDA(At, 0, 0); PG8_STAGE(PG8_SA(1, 1), a1 + hstepA, voffA);
            PG8_WAIT_V(8); PG8_WAIT_L(0); PG8_BAR; PG8_MMA(0, 0, At, B0); PG8_MMA(0, 1, At, B1); PG8_BAR; PG8_SCHED;
            PG8_LDA(At, 0, 1); PG8_STAGE(PG8_SB(0, 0), b2, voffB); PG8_STAGE(PG8_SB(0, 1), b2 + hstepB, voffB); PG8_STAGE(PG8_SA(0, 0), a2, voffA);
            PG8_WAIT_V(8); PG8_WAIT_L(0); PG8_BAR; PG8_MMA(1, 0, At, B0); PG8_MMA(1, 1, At, B1); PG8_BAR; PG8_SCHED;
            PG8_LDB(B0, 1, 0); PG8_LDB(B1, 1, 1); PG8_SCHED; PG8_LDA(At, 1, 0); PG8_STAGE(PG8_SA(0, 1), a2 + hstepA, voffA);
            PG8_WAIT_V(8); PG8_WAIT_L(0); PG8_BAR; PG8_MMA(0, 0, At, B0); PG8_MMA(0, 1, At, B1); PG8_BAR; PG8_SCHED;
            PG8_LDA(At, 1, 1); PG8_STAGE(PG8_SB(1, 0), b3, voffB); PG8_STAGE(PG8_SB(1, 1), b3 + hstepB, voffB); PG8_STAGE(PG8_SA(1, 0), a3, voffA);
            PG8_WAIT_V(8); PG8_WAIT_L(0); PG8_BAR; PG8_MMA(1, 0, At, B0); PG8_MMA(1, 1, At, B1); PG8_BAR; PG8_SCHED;
        }
        if (wr == 0) PG8_BAR;
        E(acc, cur, wr, wc, fr, fq);
        if (!has_next) break;
#pragma unroll
        for (int a = 0; a < 2; ++a)
#pragma unroll
            for (int b = 0; b < 2; ++b)
#pragma unroll
                for (int m = 0; m < 4; ++m)
#pragma unroll
                    for (int n = 0; n < 2; ++n) acc[a][b][m][n] = (f32x4){0.f, 0.f, 0.f, 0.f};
        cur = nxt; cA = nA; cB = nB; ++ui;
        if (wr == 1) PG8_BAR;
    }
    PG8_WAIT_V(0);
    PG8_BAR;
#undef PG8_SA
#undef PG8_SB
#undef PG8_STAGE
#undef PG8_LDA
#undef PG8_LDB
#undef PG8_MMA
#undef PG8_WAIT_V
#undef PG8_WAIT_L
#undef PG8_BAR
#undef PG8_SCHED
}

struct EpiZ {
    static constexpr bool PERM = true;
    bf16_t* Z; const float* bias;
    __device__ __forceinline__ void operator()(const f32x4 (&acc)[2][2][4][2], const Unit& u, int wr, int wc, int fr, int fq) const {
        const int pn = u.pn;
        int mode = 0;
        if (pn == 8 || pn == 9) mode = 2; else if (pn >= 20 && pn < 36) mode = 4;
        const bool tail = (pn == 36);
        if (tail && wc != 0) return;
        const int row0 = u.pm * BM + wr * 64 + fr; const int col0 = pn * BM + wc * 32 + 8 * fq;
#pragma unroll
        for (int bj = 0; bj < 2; ++bj) {
            if (tail && bj == 1) break;
            const f32x4 b0 = *(const f32x4*)(bias + col0 + bj * HALF), b1 = *(const f32x4*)(bias + col0 + bj * HALF + 4);
#pragma unroll
            for (int ai = 0; ai < 2; ++ai)
#pragma unroll
                for (int m = 0; m < 4; ++m) {
                    f32x4 v0 = acc[ai][bj][m][0] + b0, v1 = acc[ai][bj][m][1] + b1;
                    float f[8] = {v0[0], v0[1], v0[2], v0[3], v1[0], v1[1], v1[2], v1[3]};
                    if (mode == 1) {
#pragma unroll
                        for (int e = 0; e < 8; ++e) f[e] = gelu_tanh(f[e]);
                    } else if (mode == 2) {
#pragma unroll
                        for (int e = 0; e < 8; ++e) f[e] *= 0.08838834764831845f;
                    } else if (mode == 3) {
#pragma unroll
                        for (int e = 0; e < 8; ++e) f[e] = f[e] * sigmoid_f(f[e]);
                    } else if (mode == 4) {
#pragma unroll
                        for (int e = 0; e < 8; ++e) f[e] = sigmoid_f(f[e]);
                    }
                    __builtin_nontemporal_store(pack8(f), (u32x4*)(Z + (size_t)(row0 + ai * HALF + m * 16) * LDZ + col0 + bj * HALF));
                }
        }
    }
};
template <bool HAS_ADD> struct EpiGate {
    static constexpr bool PERM = true;
    bf16_t* dst; const bf16_t* gate; const bf16_t* add;
    __device__ __forceinline__ void operator()(const f32x4 (&acc)[2][2][4][2], const Unit& u, int wr, int wc, int fr, int fq) const {
        const int row0 = u.pm * BM + wr * 64 + fr; const int col0 = u.pn * BM + wc * 32 + 8 * fq;
#pragma unroll
        for (int ai = 0; ai < 2; ++ai)
#pragma unroll
          for (int mh = 0; mh < 2; ++mh) {
            u32x4 gv[4][2], av[4][2];
#pragma unroll
            for (int m = 2 * mh; m < 2 * mh + 2; ++m)
#pragma unroll
                for (int bj = 0; bj < 2; ++bj) {
                    const size_t off = (size_t)(row0 + ai * HALF + m * 16) * LDZ + col0 + bj * HALF;
                    gv[m][bj] = *(const u32x4*)(gate + off);
                    if (HAS_ADD) av[m][bj] = *(const u32x4*)(add + off);
                }
#pragma unroll
            for (int m = 2 * mh; m < 2 * mh + 2; ++m)
#pragma unroll
                for (int bj = 0; bj < 2; ++bj) {
                    const size_t off = (size_t)(row0 + ai * HALF + m * 16) * LDZ + col0 + bj * HALF;
                    float gt[8]; unpack8(gv[m][bj], gt);
                    const f32x4 v0 = acc[ai][bj][m][0], v1 = acc[ai][bj][m][1];
                    float f[8] = {v0[0] * gt[0], v0[1] * gt[1], v0[2] * gt[2], v0[3] * gt[3], v1[0] * gt[4], v1[1] * gt[5], v1[2] * gt[6], v1[3] * gt[7]};
                    if (HAS_ADD) { float ad[8]; unpack8(av[m][bj], ad);
#pragma unroll
                        for (int e = 0; e < 8; ++e) f[e] += ad[e]; }
                    *(u32x4*)(dst + off) = pack8(f);
                }
        }
    }
};
template <bool NORM> struct EpiRes {
    static constexpr bool PERM = false;
    float* X; const float* stats; const float* gam; const float* bet; bool dry;
    __device__ __forceinline__ void operator()(const f32x4 (&acc)[2][2][4][2], const Unit& u, int wr, int wc, int fr, int fq) const {
        const int row0 = u.pm * BM + wr * 64 + fr; const int col0 = u.pn * BM + wc * 32 + 4 * fq;
#pragma unroll
        for (int bj = 0; bj < 2; ++bj)
#pragma unroll
            for (int n = 0; n < 2; ++n) {
                const int col = col0 + bj * HALF + n * 16;
                f32x4 gg = {1.f, 1.f, 1.f, 1.f}, bb = {0.f, 0.f, 0.f, 0.f};
                if (NORM) { gg = *(const f32x4*)(gam + col); bb = *(const f32x4*)(bet + col); }
#pragma unroll
                for (int ai = 0; ai < 2; ++ai) {
                    f32x4 xv[4]; f32x2 st[4];
#pragma unroll
                    for (int m = 0; m < 4; ++m) { xv[m] = *(const f32x4*)(X + (size_t)(row0 + ai * HALF + m * 16) * D + col);
                        if (NORM) st[m] = *(const f32x2*)(stats + 2 * (row0 + ai * HALF + m * 16)); }
#pragma unroll
                    for (int m = 0; m < 4; ++m) {
                        f32x4 x = xv[m];
                        if (NORM) x = (x - st[m].x) * st[m].y * gg + bb;
                        if (!dry) *(f32x4*)(X + (size_t)(row0 + ai * HALF + m * 16) * D + col) = x * ALPHA + acc[ai][bj][m][n];
                    }
                }
            }
    }
};
struct EpiBf16 {
    static constexpr bool PERM = true;
    bf16_t* O; int ld;
    __device__ __forceinline__ void operator()(const f32x4 (&acc)[2][2][4][2], const Unit& u, int wr, int wc, int fr, int fq) const {
        const int row0 = u.pm * BM + wr * 64 + fr; const int col0 = u.pn * BM + wc * 32 + 8 * fq;
#pragma unroll
        for (int ai = 0; ai < 2; ++ai)
#pragma unroll
            for (int m = 0; m < 4; ++m)
#pragma unroll
                for (int bj = 0; bj < 2; ++bj) {
                    const f32x4 v0 = acc[ai][bj][m][0], v1 = acc[ai][bj][m][1];
                    u32x4 w; w.x = cvt_pk_bf16(v0[0], v0[1]); w.y = cvt_pk_bf16(v0[2], v0[3]); w.z = cvt_pk_bf16(v1[0], v1[1]); w.w = cvt_pk_bf16(v1[2], v1[3]);
                    __builtin_nontemporal_store(w, (u32x4*)(O + (size_t)(row0 + ai * HALF + m * 16) * ld + col0 + bj * HALF));
                }
    }
};
}


#define XB_TMO      128
#define XB_XCNT(j)  (256  + 64 * (j))
#define XB_XSUB(j)  (1280 + 64 * (j))
#define XB_XGEN(j)  (2304 + 64 * (j))
#define XB_TOP      3328
#define XB_TOPGEN   3392
#define XCD_BAR_WORDS 3456
#define XB_SPIN_CAP (1u << 22)
__device__ __forceinline__ unsigned xb_ld(unsigned* p)              { return __hip_atomic_load(p, __ATOMIC_RELAXED, __HIP_MEMORY_SCOPE_AGENT); }
__device__ __forceinline__ unsigned xb_add(unsigned* p, unsigned v) { return __hip_atomic_fetch_add(p, v, __ATOMIC_RELAXED, __HIP_MEMORY_SCOPE_AGENT); }
__device__ __forceinline__ unsigned xb_xcc_id() { return (unsigned)__builtin_amdgcn_s_getreg((3 << 11) | 20) & 0xFu; }
#define XB_SPIN(cond, bar) do { unsigned _sp = 0; while (cond) { __builtin_amdgcn_s_sleep(1); \
    if ((++_sp & 255u) == 0u) { if (xb_ld(&(bar)[XB_TMO])) break; if (_sp > XB_SPIN_CAP) { atomicAdd(&(bar)[XB_TMO], 1u); break; } } } } while (0)
__device__ __forceinline__ void xcd_barrier_complete(unsigned* bar, unsigned x, unsigned& nloc, unsigned& nx) {
    const unsigned G = gridDim.x * gridDim.y * gridDim.z;
    unsigned sum, cnt, mine, sp = 0u;
    for (;;) {
        sum = 0u; cnt = 0u; mine = 0u;
#pragma unroll
        for (unsigned j = 0; j < 16; ++j) { const unsigned c = xb_ld(&bar[XB_XCNT(j)]); sum += c; cnt += (c > 0u) ? 1u : 0u; mine = (j == x) ? c : mine; }
        if (sum == G) break;
        __builtin_amdgcn_s_sleep(1);
        if ((++sp & 255u) == 0u) { if (xb_ld(&bar[XB_TMO])) break; if (sp > XB_SPIN_CAP) { atomicAdd(&bar[XB_TMO], 1u); break; } }
    }
    nloc = mine > 0u ? mine : 1u; nx = cnt > 0u ? cnt : 1u;
}
__device__ __forceinline__ void xcd_barrier(unsigned* bar, volatile LAS unsigned* st) {
    asm volatile("s_waitcnt vmcnt(0)" ::: "memory");
    __syncthreads();
    if (threadIdx.x == 0) {
        const unsigned x = xb_xcc_id();
        __builtin_amdgcn_s_waitcnt(0);
        unsigned nloc = st[0], nx = st[1];
        if (nloc == 0u) { xcd_barrier_complete(bar, x, nloc, nx); st[0] = nloc; st[1] = nx; }
        const unsigned old = xb_add(&bar[XB_XSUB(x)], 1u);
        const unsigned gen = old / nloc;
        if (old + 1u == (gen + 1u) * nloc) {
            __builtin_amdgcn_fence(__ATOMIC_RELEASE, "agent");
            asm volatile("s_waitcnt vmcnt(0)" ::: "memory");
            const unsigned og = xb_add(&bar[XB_TOP], 1u);
            const unsigned tg = og / nx;
            if (og + 1u == (tg + 1u) * nx) xb_add(&bar[XB_TOPGEN], 1u);
            else XB_SPIN(xb_ld(&bar[XB_TOPGEN]) == tg, bar);
            __builtin_amdgcn_fence(__ATOMIC_ACQUIRE, "agent");
            xb_add(&bar[XB_XGEN(x)], 1u);
            asm volatile("s_waitcnt vmcnt(0)" ::: "memory");
        } else {
            XB_SPIN(xb_ld(&bar[XB_XGEN(x)]) == gen, bar);
            __builtin_amdgcn_fence(__ATOMIC_ACQUIRE, "agent");
            asm volatile("s_waitcnt vmcnt(0)" ::: "memory");
        }
    }
    __syncthreads();
}
constexpr int LDS_MISC = LDS_BYTES - 64;

struct Args { const float* in[27]; float* out; unsigned char* ws; int ph_lo, ph_hi; };
static_assert(sizeof(Args) == 27 * 8 + 8 + 8 + 8, "no padding");
enum { I_XP = 0, I_XS, I_LNIG, I_LNIB, I_WIN, I_BIN, I_CRW, I_CRB, I_RWA, I_RBA, I_RWX, I_RBX, I_LAM, I_WG2, I_BG, I_NW, I_WPA, I_WPB, I_WOUT, I_LMG, I_LMB, I_WUP, I_CFW, I_CFB, I_WDN, I_LFG, I_LFB };

__device__ __forceinline__ void transpose_item(const float* W, int K, int N, bf16_t* WT, int k0, int n0, int drow, LAS float* scr, int lane) {
#pragma unroll 8
    for (int i = 0; i < 32; ++i) { const int kk = 2 * i + (lane >> 5); scr[kk * 33 + (lane & 31)] = W[(size_t)(k0 + kk) * N + n0 + (lane & 31)]; }
    asm volatile("s_waitcnt lgkmcnt(0)" ::: "memory");
    const int c = lane & 7;
#pragma unroll
    for (int j = 0; j < 4; ++j) { const int n = (lane >> 3) + 8 * j; const LAS float* s = scr + (8 * c) * 33 + n;
        u32x4 o; o.x = cvt_pk_bf16(s[0 * 33], s[1 * 33]); o.y = cvt_pk_bf16(s[2 * 33], s[3 * 33]); o.z = cvt_pk_bf16(s[4 * 33], s[5 * 33]); o.w = cvt_pk_bf16(s[6 * 33], s[7 * 33]);
        *(u32x4*)(WT + (size_t)(drow + n) * K + k0 + 8 * c) = o; }
    asm volatile("s_waitcnt lgkmcnt(0)" ::: "memory");
}
__device__ __forceinline__ int win_colmap(int n) { return n < 5120 ? n : (n < 5152 ? n + 4096 : n - 32); }

__device__ __forceinline__ void phase_convert(const Args& a, LAS unsigned char* lds, int G, int b, int tid) {
    const int wave = tid >> 6, lane = tid & 63;
    LAS float* scr = (LAS float*)(lds + wave * 16384);
    const int gw = b * 8 + wave, NGW = G * 8;
    constexpr int I_IN = 32 * 289, I_UP = 32 * 384, I_DN = 96 * 64, I_OUT = 32 * 64, I_PA = 16 * 64, I_L = I_IN + I_UP + I_DN + I_OUT + 2 * I_PA;
    for (int it = gw; it < DEPTH * I_L; it += NGW) {
        const int l = it / I_L; int r = it % I_L;
        unsigned char* lw = a.ws + (size_t)l * LW_SIZE;
        if (r < I_IN) { const int kb = r / 289, nb = r % 289; transpose_item(a.in[I_WIN] + (size_t)l * D * LDZ, D, LDZ, (bf16_t*)(lw + LW_WIN), kb * 64, nb * 32, win_colmap(nb * 32), scr, lane); continue; } r -= I_IN;
        if (r < I_UP) { const int kb = r / 384, nb = r % 384; transpose_item(a.in[I_WUP] + (size_t)l * D * 2 * DFF, D, 2 * DFF, (bf16_t*)(lw + LW_WUP), kb * 64, nb * 32, nb * 32, scr, lane); continue; } r -= I_UP;
        if (r < I_DN) { const int kb = r / 64, nb = r % 64; transpose_item(a.in[I_WDN] + (size_t)l * DFF * D, DFF, D, (bf16_t*)(lw + LW_WDN), kb * 64, nb * 32, nb * 32, scr, lane); continue; } r -= I_DN;
        if (r < I_OUT) { const int kb = r / 64, nb = r % 64; transpose_item(a.in[I_WOUT] + (size_t)l * D * D, D, D, (bf16_t*)(lw + LW_WOUT), kb * 64, nb * 32, nb * 32, scr, lane); continue; } r -= I_OUT;
        if (r < I_PA) { const int kb = r / 64, nb = r % 64; transpose_item(a.in[I_WPA] + (size_t)l * DRNN * D, DRNN, D, (bf16_t*)(lw + LW_WPA), kb * 64, nb * 32, nb * 32, scr, lane); continue; } r -= I_PA;
        { const int kb = r / 64, nb = r % 64; transpose_item(a.in[I_WPB] + (size_t)l * DRNN * D, DRNN, D, (bf16_t*)(lw + LW_WPB), kb * 64, nb * 32, nb * 32, scr, lane); }
    }
    const int gt = b * 512 + tid, NT = G * 512;
    for (int i = gt; i < DEPTH * 224 * 256; i += NT) { const int l = i / (224 * 256), r = i % (224 * 256);
        *(u32x4*)(a.ws + (size_t)l * LW_SIZE + LW_WIN + (size_t)LDZ * D * 2 + (size_t)r * 16) = (u32x4){0u, 0u, 0u, 0u}; }
    for (int i = gt; i < DEPTH * NZ; i += NT) { const int l = i / NZ, n = i % NZ; float* bp = (float*)(a.ws + (size_t)l * LW_SIZE + LW_BIAS);
        if (n >= LDZ) bp[n] = 0.f; else bp[win_colmap(n)] = a.in[I_BIN][(size_t)l * LDZ + n]; }
    for (int i = gt; i < DEPTH * 2 * 2 * 16 * 4096; i += NT) {
        const int ii = i & 63, j = (i >> 6) & 63, n = (i >> 12) & 15, dir = (i >> 16) & 1, which = (i >> 17) & 1, l = i >> 18;
        const float* src = which ? a.in[I_RWX] : a.in[I_RWA];
        const float v = src[((((size_t)l * 2 + dir) * 16 + n) * 64 + ii) * 64 + j];
        ((bf16_t*)(a.ws + (size_t)l * LW_SIZE + LW_RGW))[i & 262143] = f2bf(v);
    }
}

__device__ __forceinline__ void ln_row(const float* src, float* dstf, bf16_t* dstb, const float* gam, const float* bet, int lane, float* stat = nullptr) {
    const f32x4* s4 = (const f32x4*)src + lane;
    f32x4 v[8]; float s = 0.f;
#pragma unroll
    for (int j = 0; j < 8; ++j) { v[j] = s4[64 * j]; s += (v[j].x + v[j].y) + (v[j].z + v[j].w); }
    const float mean = wave_sum(s) * (1.f / D); float s2 = 0.f;
#pragma unroll
    for (int j = 0; j < 8; ++j) { v[j] = v[j] - mean; s2 += (v[j].x * v[j].x + v[j].y * v[j].y) + (v[j].z * v[j].z + v[j].w * v[j].w); }
    const float rstd = 1.f / sqrtf(wave_sum(s2) * (1.f / D) + EPS);
    if (stat && lane == 0) { stat[0] = mean; stat[1] = rstd; }
#pragma unroll
    for (int j = 0; j < 8; ++j) {
        const f32x4 gg = ((const f32x4*)gam)[lane + 64 * j], bb = ((const f32x4*)bet)[lane + 64 * j];
        const f32x4 o = v[j] * rstd * gg + bb;
        if (dstf) ((f32x4*)dstf)[lane + 64 * j] = o;
        if (dstb) { u32x2 w; w.x = cvt_pk_bf16(o.x, o.y); w.y = cvt_pk_bf16(o.z, o.w); ((u32x2*)dstb)[lane + 64 * j] = w; }
    }
}

template <int NR>
__device__ __forceinline__ void ln_rows(const float* src, float* dstf, bf16_t* dstb, float* stat, size_t rstride, const float* gam, const float* bet, int lane) {
    f32x4 v[NR][8]; float mean[NR], rstd[NR];
#pragma unroll
    for (int r = 0; r < NR; ++r)
#pragma unroll
        for (int j = 0; j < 8; ++j) v[r][j] = ((const f32x4*)(src + r * rstride * D))[lane + 64 * j];
#pragma unroll
    for (int r = 0; r < NR; ++r) {
        float s = 0.f;
#pragma unroll
        for (int j = 0; j < 8; ++j) s += (v[r][j].x + v[r][j].y) + (v[r][j].z + v[r][j].w);
        mean[r] = wave_sum(s) * (1.f / D); float s2 = 0.f;
#pragma unroll
        for (int j = 0; j < 8; ++j) { v[r][j] = v[r][j] - mean[r]; s2 += (v[r][j].x * v[r][j].x + v[r][j].y * v[r][j].y) + (v[r][j].z * v[r][j].z + v[r][j].w * v[r][j].w); }
        rstd[r] = 1.f / sqrtf(wave_sum(s2) * (1.f / D) + EPS);
        if (stat && lane == 0) { stat[2 * r * rstride] = mean[r]; stat[2 * r * rstride + 1] = rstd[r]; }
    }
#pragma unroll
    for (int j = 0; j < 8; ++j) {
        const f32x4 gg = ((const f32x4*)gam)[lane + 64 * j], bb = ((const f32x4*)bet)[lane + 64 * j];
#pragma unroll
        for (int r = 0; r < NR; ++r) {
            const f32x4 o = v[r][j] * rstd[r] * gg + bb;
            if (dstf) ((f32x4*)(dstf + r * rstride * D))[lane + 64 * j] = o;
            if (dstb) { u32x2 p; p.x = cvt_pk_bf16(o.x, o.y); p.y = cvt_pk_bf16(o.z, o.w); ((u32x2*)(dstb + r * rstride * D))[lane + 64 * j] = p; }
        }
    }
}

constexpr int RG_XF = 0, RG_XB = 32768, RG_HF = 51200, RG_HB = 83968;
struct RgCtx { const bf16_t* Z; const float* cw; const float* cb; const bf16_t* rgw; const float* ba; const float* bx; const float* lam; float* carry; bf16_t* HA; int SL; };
template <int MODE, int DIR>
__device__ __forceinline__ void rg_wave(LAS unsigned char* lds, const RgCtx& c, int tile, int n, int ct, int lane) {
    const int fr = lane & 15, fq = lane >> 4, cl = 16 * ct + fr, ch = n * 64 + cl;
    bf16x8 Ba[2], Bx[2];
#pragma unroll
    for (int ks = 0; ks < 2; ++ks) {
        Ba[ks] = *(const bf16x8*)(c.rgw + ((((size_t)0 * 2 + DIR) * 16 + n) * 64 + cl) * 64 + 32 * ks + 8 * fq);
        Bx[ks] = *(const bf16x8*)(c.rgw + ((((size_t)1 * 2 + DIR) * 16 + n) * 64 + cl) * 64 + 32 * ks + 8 * fq);
    }
    const float ba = c.ba[DIR * DRNN + ch], bx = c.bx[DIR * DRNN + ch], lam = c.lam[DIR * DRNN + ch];
    const float c8sp = -8.f * log1pf(__expf(-lam));
    float* cA = c.carry + ((size_t)(0 * 2 + DIR) * 128) * DRNN; float* cH = c.carry + ((size_t)(1 * 2 + DIR) * 128) * DRNN;
    float Hc = 0.f, Ac = 1.f;
    if (MODE == 1) {
        const int tps = c.SL / 128, s0 = (tile / tps) * tps;
        const int first = DIR ? s0 + tps - 1 : s0, cnt = DIR ? (s0 + tps - 1 - tile) : (tile - s0);
        for (int k0 = 0; k0 < cnt; k0 += 8) {
            float a8[8], h8[8];
#pragma unroll
            for (int k = 0; k < 8; ++k) { const bool ok = (k0 + k) < cnt; const int pp = DIR ? first - (k0 + k) : first + (k0 + k);
                a8[k] = ok ? cA[(size_t)pp * DRNN + ch] : 1.f; h8[k] = ok ? cH[(size_t)pp * DRNN + ch] : 0.f; }
#pragma unroll
            for (int k = 0; k < 8; ++k) Hc = a8[k] * Hc + h8[k];
        }
    }
    const LAS float* XF = (const LAS float*)(lds + RG_XF);
    LAS float* HO = (LAS float*)(lds + (DIR ? RG_HB : RG_HF));
#pragma unroll 4
    for (int rti = 0; rti < 8; ++rti) {
        const int rt = DIR ? 7 - rti : rti;
        const bf16x8 A0 = *(const LAS bf16x8*)(lds + RG_XB + (16 * rt + fr) * 144 + 16 * fq);
        const bf16x8 A1 = *(const LAS bf16x8*)(lds + RG_XB + (16 * rt + fr) * 144 + 64 + 16 * fq);
        f32x4 racc = {0.f, 0.f, 0.f, 0.f}, iacc = {0.f, 0.f, 0.f, 0.f};
        racc = __builtin_amdgcn_mfma_f32_16x16x32_bf16(A0, Ba[0], racc, 0, 0, 0); racc = __builtin_amdgcn_mfma_f32_16x16x32_bf16(A1, Ba[1], racc, 0, 0, 0);
        iacc = __builtin_amdgcn_mfma_f32_16x16x32_bf16(A0, Bx[0], iacc, 0, 0, 0); iacc = __builtin_amdgcn_mfma_f32_16x16x32_bf16(A1, Bx[1], iacc, 0, 0, 0);
        f32x4 av4, uu4;
        {
            const f32x4 c60 = {60.f, 60.f, 60.f, 60.f};
            const f32x4 ta = __builtin_elementwise_min((racc + ba) * (-1.4426950408889634f), c60), tb = __builtin_elementwise_min((iacc + bx) * (-1.4426950408889634f), c60);
            f32x4 ea, eb;
#pragma unroll
            for (int j = 0; j < 4; ++j) { ea[j] = __builtin_amdgcn_exp2f(ta[j]); eb[j] = __builtin_amdgcn_exp2f(tb[j]); }
            const f32x4 da = ea + 1.f, db = eb + 1.f, dd = da * db;
            f32x4 R;
#pragma unroll
            for (int j = 0; j < 4; ++j) R[j] = __builtin_amdgcn_rcpf(dd[j]);
            const f32x4 r4 = db * R, ig4 = da * R;
            const f32x4 la2 = r4 * (c8sp * 1.4426950408889634f);
#pragma unroll
            for (int j = 0; j < 4; ++j) av4[j] = __builtin_amdgcn_exp2f(la2[j]);
            f32x4 om = 1.f - av4 * av4, xv4;
#pragma unroll
            for (int j = 0; j < 4; ++j) { om[j] = __builtin_amdgcn_sqrtf(fmaxf(om[j], 0.f)); xv4[j] = XF[(16 * rt + 4 * fq + j) * 64 + cl]; }
            uu4 = om * ig4 * xv4;
        }
        float hl[4], al[4]; float hp = 0.f, ap = 1.f;
#pragma unroll
        for (int jj = 0; jj < 4; ++jj) {
            const int j = DIR ? 3 - jj : jj;
            hp = av4[j] * hp + uu4[j]; ap = ap * av4[j]; hl[j] = hp; al[j] = ap;
        }
        float Hrun = Hc, Hin = 0.f, Aall = 1.f;
#pragma unroll
        for (int qq = 0; qq < 4; ++qq) {
            const int q = DIR ? 3 - qq : qq;
            const float Aq = __shfl(ap, fr + 16 * q), Hq = __shfl(hp, fr + 16 * q);
            if (q == fq) Hin = Hrun;
            Hrun = Aq * Hrun + Hq; Aall *= Aq;
        }
        Hc = Hrun; Ac *= Aall;
        if (MODE == 1) {
#pragma unroll
            for (int j = 0; j < 4; ++j) HO[(16 * rt + 4 * fq + j) * 64 + cl] = hl[j] + al[j] * Hin;
        }
    }
    if (MODE == 0 && fq == 0) { cA[(size_t)tile * DRNN + ch] = Ac; cH[(size_t)tile * DRNN + ch] = Hc; }
}

template <int MODE>
__device__ __forceinline__ void rg_tile(LAS unsigned char* lds, const RgCtx& c, int tile, int n, int tid) {
    const int wave = __builtin_amdgcn_readfirstlane(tid >> 6), lane = tid & 63;
    const int t0 = tile * 128;
    {
        const int c8 = tid & 7, tr = tid >> 3, ch0 = n * 64 + c8 * 8;
        f32x4 w[4][2], bb[2];
#pragma unroll
        for (int j = 0; j < 4; ++j) { w[j][0] = *(const f32x4*)(c.cw + j * DRNN + ch0); w[j][1] = *(const f32x4*)(c.cw + j * DRNN + ch0 + 4); }
        bb[0] = *(const f32x4*)(c.cb + ch0); bb[1] = *(const f32x4*)(c.cb + ch0 + 4);
#pragma unroll
        for (int h = 0; h < 2; ++h) {
            const int rr = tr + 64 * h, t = t0 + rr, pos = t & (c.SL - 1);
            float x[8] = {bb[0][0], bb[0][1], bb[0][2], bb[0][3], bb[1][0], bb[1][1], bb[1][2], bb[1][3]};
#pragma unroll
            for (int j = 0; j < 4; ++j) {
                const int pp = pos + j - 2;
                if (pp >= 0 && pp < c.SL) {
                    float zf[8]; unpack8(*(const u32x4*)(c.Z + (size_t)(t + j - 2) * LDZ + ZC_RX + ch0), zf);
#pragma unroll
                    for (int e = 0; e < 8; ++e) x[e] += w[j][e >> 2][e & 3] * zf[e];
                }
            }
            *(LAS f32x4*)(lds + RG_XF + (rr * 64 + c8 * 8) * 4) = (f32x4){x[0], x[1], x[2], x[3]};
            *(LAS f32x4*)(lds + RG_XF + (rr * 64 + c8 * 8 + 4) * 4) = (f32x4){x[4], x[5], x[6], x[7]};
            *(LAS u32x4*)(lds + RG_XB + rr * 144 + c8 * 16) = pack8(x);
        }
    }
    u32x4 gpre[2] = {{0u, 0u, 0u, 0u}, {0u, 0u, 0u, 0u}};
    if (MODE == 1) { const int tok = tid >> 2, cs = (tid & 3) * 16;
#pragma unroll
        for (int h = 0; h < 2; ++h) gpre[h] = *(const u32x4*)(c.Z + (size_t)(t0 + tok) * LDZ + ZC_RG + n * 64 + cs + 8 * h); }
    WG_BARRIER();
    if (wave < 4) rg_wave<MODE, 0>(lds, c, tile, n, wave & 3, lane); else rg_wave<MODE, 1>(lds, c, tile, n, wave & 3, lane);
    WG_BARRIER();
    if (MODE == 1) {
        const int tok = tid >> 2, cs = (tid & 3) * 16;
        const LAS float* hf = (const LAS float*)(lds + RG_HF) + tok * 64 + cs; const LAS float* hb = (const LAS float*)(lds + RG_HB) + tok * 64 + cs;
#pragma unroll
        for (int h = 0; h < 2; ++h) {
            float gt[8]; unpack8(gpre[h], gt);
#pragma unroll
            for (int e = 0; e < 8; ++e) gt[e] = gelu_tanh(gt[e]);
            const f32x4 f0 = *(const LAS f32x4*)(hf + 8 * h), f1 = *(const LAS f32x4*)(hf + 8 * h + 4), b0 = *(const LAS f32x4*)(hb + 8 * h), b1 = *(const LAS f32x4*)(hb + 8 * h + 4);
            float o[8] = {gt[0] * (f0[0] + b0[0]), gt[1] * (f0[1] + b0[1]), gt[2] * (f0[2] + b0[2]), gt[3] * (f0[3] + b0[3]),
                          gt[4] * (f1[0] + b1[0]), gt[5] * (f1[1] + b1[1]), gt[6] * (f1[2] + b1[2]), gt[7] * (f1[3] + b1[3])};
            *(u32x4*)(c.HA + (size_t)(t0 + tok) * DRNN + n * 64 + cs + 8 * h) = pack8(o);
        }
    }
}

template <int MODE>
__device__ __forceinline__ void rg_phase(LAS unsigned char* lds, const RgCtx& c, int u0, int ustride, int tid) {
    constexpr int NU = 128 * 16;
    if (u0 >= NU) return;
    const int wave = __builtin_amdgcn_readfirstlane(tid >> 6), lane = tid & 63;
    const int c8 = tid & 7, tr = tid >> 3;
    u32x4 zr[2][4];
#define RG_LOAD(u_) do { const int tile_ = (u_) >> 4, ch0_ = ((u_) & 15) * 64 + c8 * 8; \
        _Pragma("unroll") for (int hh = 0; hh < 2; ++hh) { const int t_ = tile_ * 128 + tr + 64 * hh, pos_ = t_ & (c.SL - 1); \
            _Pragma("unroll") for (int j = 0; j < 4; ++j) { const int pp_ = pos_ + j - 2; const int tt_ = (pp_ >= 0 && pp_ < c.SL) ? t_ + j - 2 : t_;     \
                zr[hh][j] = *(const u32x4*)(c.Z + (size_t)tt_ * LDZ + ZC_RX + ch0_); } } } while (0)
    RG_LOAD(u0);
    const bool nconst = (ustride & 15) == 0;
    f32x4 w[4][2], bb[2];
#define RG_WLOAD(n_) do { const int ch0_ = (n_) * 64 + c8 * 8; \
        _Pragma("unroll") for (int j = 0; j < 4; ++j) { w[j][0] = *(const f32x4*)(c.cw + j * DRNN + ch0_); w[j][1] = *(const f32x4*)(c.cw + j * DRNN + ch0_ + 4); } \
        bb[0] = *(const f32x4*)(c.cb + ch0_); bb[1] = *(const f32x4*)(c.cb + ch0_ + 4); } while (0)
    RG_WLOAD(u0 & 15);
#pragma unroll 1
    for (int u = u0; u < NU; u += ustride) {
        const int tile = u >> 4, n = u & 15, t0 = tile * 128;
        {
            if (!nconst) RG_WLOAD(n);
#pragma unroll
            for (int h = 0; h < 2; ++h) {
                const int rr = tr + 64 * h, t = t0 + rr, pos = t & (c.SL - 1);
                float x[8] = {bb[0][0], bb[0][1], bb[0][2], bb[0][3], bb[1][0], bb[1][1], bb[1][2], bb[1][3]};
#pragma unroll
                for (int j = 0; j < 4; ++j) {
                    const int pp = pos + j - 2;
                    float zf[8]; unpack8(zr[h][j], zf);
                    const float msk = (pp >= 0 && pp < c.SL) ? 1.f : 0.f;
#pragma unroll
                    for (int e = 0; e < 8; ++e) x[e] += w[j][e >> 2][e & 3] * (zf[e] * msk);
                }
                *(LAS f32x4*)(lds + RG_XF + (rr * 64 + c8 * 8) * 4) = (f32x4){x[0], x[1], x[2], x[3]};
                *(LAS f32x4*)(lds + RG_XF + (rr * 64 + c8 * 8 + 4) * 4) = (f32x4){x[4], x[5], x[6], x[7]};
                *(LAS u32x4*)(lds + RG_XB + rr * 144 + c8 * 16) = pack8(x);
            }
        }
        u32x4 gpre[2] = {{0u, 0u, 0u, 0u}, {0u, 0u, 0u, 0u}};
        if (MODE == 1) { const int tok = tid >> 2, cs = (tid & 3) * 16;
#pragma unroll
            for (int h = 0; h < 2; ++h) gpre[h] = *(const u32x4*)(c.Z + (size_t)(t0 + tok) * LDZ + ZC_RG + n * 64 + cs + 8 * h); }
        { const int un = (u + ustride < NU) ? u + ustride : u; RG_LOAD(un); }
        WG_BARRIER();
        if (wave < 4) rg_wave<MODE, 0>(lds, c, tile, n, wave & 3, lane); else rg_wave<MODE, 1>(lds, c, tile, n, wave & 3, lane);
        WG_BARRIER();
        if (MODE == 1) {
            const int tok = tid >> 2, cs = (tid & 3) * 16;
            const LAS float* hf = (const LAS float*)(lds + RG_HF) + tok * 64 + cs; const LAS float* hb = (const LAS float*)(lds + RG_HB) + tok * 64 + cs;
#pragma unroll
            for (int h = 0; h < 2; ++h) {
                float gt[8]; unpack8(gpre[h], gt);
#pragma unroll
                for (int e = 0; e < 8; ++e) gt[e] = gelu_tanh(gt[e]);
                const f32x4 f0 = *(const LAS f32x4*)(hf + 8 * h), f1 = *(const LAS f32x4*)(hf + 8 * h + 4), b0 = *(const LAS f32x4*)(hb + 8 * h), b1 = *(const LAS f32x4*)(hb + 8 * h + 4);
                float o[8] = {gt[0] * (f0[0] + b0[0]), gt[1] * (f0[1] + b0[1]), gt[2] * (f0[2] + b0[2]), gt[3] * (f0[3] + b0[3]),
                              gt[4] * (f1[0] + b1[0]), gt[5] * (f1[1] + b1[1]), gt[6] * (f1[2] + b1[2]), gt[7] * (f1[3] + b1[3])};
                *(u32x4*)(c.HA + (size_t)(t0 + tok) * DRNN + n * 64 + cs + 8 * h) = pack8(o);
            }
        }
    }
#undef RG_LOAD
#undef RG_WLOAD
}

constexpr int GL_QD = 0, GL_KD = 17408, GL_KET = 34816, GL_VT = 53248, GL_ATT = 62464, GL_ST = 71680, GL_GCS = 89088  , GL_GS = 122880, GL_DEC = 123392, GL_ZGS = 123904;
constexpr int GCS_LD = 132;
struct GlaCtx { const bf16_t* Z; const float* wg2; const float* bg; bf16_t* OF; bf16_t* OK; bf16_t* QDG; bf16_t* KDG; bf16_t* KETG; float* DECG; bf16_t* ATTG; int SL; };
constexpr int NCKG = TG / 64;
template <int DIR>
__device__ __forceinline__ void gla_pre(LAS unsigned char* lds, const GlaCtx& c, int ck, int h, int tid) {
    const int wave = __builtin_amdgcn_readfirstlane(tid >> 6), lane = tid & 63, fr = lane & 15, fq = lane >> 4;
    const int ct_ = tid >> 3, sub = tid & 7;
    bf16x8 wgB;
    {
        float wv[8];
#pragma unroll
        for (int i = 0; i < 8; ++i) wv[i] = (fq < 2) ? c.wg2[((size_t)DIR * 16 + 8 * fq + i) * 512 + h * 128 + 16 * wave + fr] : 0.f;
        const u32x4 wp = pack8(wv); wgB = __builtin_bit_cast(bf16x8, wp);
    }
    const float bgd = c.bg[DIR * 512 + h * 128 + 16 * wave + fr];
    const size_t row0 = (size_t)ck * 64;
    const bf16_t* zr = c.Z + (row0 + ct_) * LDZ;
    u32x4 qraw[2], kraw[2];
    qraw[0] = *(const u32x4*)(zr + ZC_Q + h * 128 + sub * 16); qraw[1] = *(const u32x4*)(zr + ZC_Q + h * 128 + sub * 16 + 8);
    kraw[0] = *(const u32x4*)(zr + ZC_K + h * 128 + sub * 16); kraw[1] = *(const u32x4*)(zr + ZC_K + h * 128 + sub * 16 + 8);
    if (tid < 128) *(LAS u32x4*)(lds + GL_ZGS + (tid >> 1) * 32 + (tid & 1) * 16) = *(const u32x4*)(c.Z + (row0 + (tid >> 1)) * LDZ + ZC_GF + DIR * 16 + (tid & 1) * 8);
    WG_BARRIER();
    {
        LAS float* gcs = (LAS float*)(lds + GL_GCS);
        float carry = 0.f;
#pragma unroll
        for (int tti = 0; tti < 4; ++tti) {
            const int tt = DIR ? 3 - tti : tti;
            bf16x8 Az = {0, 0, 0, 0, 0, 0, 0, 0};
            if (fq < 2) Az = *(const LAS bf16x8*)(lds + GL_ZGS + (16 * tt + fr) * 32 + fq * 16);
            f32x4 lg4 = {0.f, 0.f, 0.f, 0.f};
            lg4 = __builtin_amdgcn_mfma_f32_16x16x32_bf16(Az, wgB, lg4, 0, 0, 0);
            float gv[4];
#pragma unroll
            for (int j = 0; j < 4; ++j) {
                const float lg = lg4[j] + bgd;
                float ls = -__logf(1.f + __expf(-fmaxf(lg, -60.f)));
                if (lg < -60.f) ls = lg;
                gv[j] = ls * 0.0625f;
            }
            float pj[4];
            if (DIR == 0) { pj[0] = gv[0]; pj[1] = pj[0] + gv[1]; pj[2] = pj[1] + gv[2]; pj[3] = pj[2] + gv[3]; }
            else { pj[3] = gv[3]; pj[2] = pj[3] + gv[2]; pj[1] = pj[2] + gv[1]; pj[0] = pj[1] + gv[0]; }
            const float T = DIR ? pj[0] : pj[3];
            const float T0 = __shfl(T, fr), T1 = __shfl(T, fr + 16), T2 = __shfl(T, fr + 32), T3 = __shfl(T, fr + 48);
            float excl = 0.f;
            if (DIR == 0) { if (fq > 0) excl += T0; if (fq > 1) excl += T1; if (fq > 2) excl += T2; }
            else { if (fq < 3) excl += T3; if (fq < 2) excl += T2; if (fq < 1) excl += T1; }
            const float base = carry + excl;
#pragma unroll
            for (int j = 0; j < 4; ++j) gcs[(16 * tt + 4 * fq + j) * GCS_LD + 16 * wave + fr] = base + pj[j];
            carry += (T0 + T1) + (T2 + T3);
        }
        if (fq == 0) ((LAS float*)(lds + GL_GS))[16 * wave + fr] = carry;
    }
    WG_BARRIER();
    {
        const LAS float* gs = (const LAS float*)(lds + GL_GS) + sub * 16;
        const LAS float* gcs = (const LAS float*)(lds + GL_GCS) + ct_ * GCS_LD + sub * 16;
        float qf[16], kf[16];
        { float t8[8]; unpack8(qraw[0], t8);
#pragma unroll
          for (int e = 0; e < 8; ++e) qf[e] = t8[e];
          unpack8(qraw[1], t8);
#pragma unroll
          for (int e = 0; e < 8; ++e) qf[8 + e] = t8[e];
          unpack8(kraw[0], t8);
#pragma unroll
          for (int e = 0; e < 8; ++e) kf[e] = t8[e];
          unpack8(kraw[1], t8);
#pragma unroll
          for (int e = 0; e < 8; ++e) kf[8 + e] = t8[e]; }
        float qd[16], kd[16];
        LAS bf16_t* ket = (LAS bf16_t*)(lds + GL_KET);
        float* decg = c.DECG + (((size_t)DIR * NCKG + ck) * 4 + h) * 128;
#pragma unroll
        for (int e4 = 0; e4 < 4; ++e4) {
            const f32x4 tt4 = *(const LAS f32x4*)(gs + 4 * e4);
            const f32x4 gl = *(const LAS f32x4*)(gcs + 4 * e4);
            if (ct_ == 0) *(f32x4*)(decg + sub * 16 + 4 * e4) = (f32x4){__expf(tt4[0]), __expf(tt4[1]), __expf(tt4[2]), __expf(tt4[3])};
#pragma unroll
            for (int e1 = 0; e1 < 4; ++e1) {
                const int e = 4 * e4 + e1;
                const float tot = tt4[e1], gc = gl[e1];
                const float eq = __expf(gc), ek = __expf(-gc), ee = __expf(tot - gc);
                qd[e] = qf[e] * eq; kd[e] = kf[e] * ek;
                ket[(sub * 16 + e) * 72 + (ct_ ^ (8 * sub))] = f2bf(kf[e] * ee);
            }
        }
        bf16_t* qg = c.QDG + ((size_t)DIR * TG + row0 + ct_) * 512 + h * 128 + sub * 16;
        bf16_t* kg = c.KDG + ((size_t)DIR * TG + row0 + ct_) * 512 + h * 128 + sub * 16;
        float t8[8];
#pragma unroll
        for (int hh = 0; hh < 2; ++hh) {
#pragma unroll
            for (int e = 0; e < 8; ++e) t8[e] = qd[8 * hh + e];
            { const u32x4 w = pack8(t8); *(u32x4*)(qg + 8 * hh) = w; *(LAS u32x4*)(lds + GL_QD + ct_ * 272 + sub * 32 + hh * 16) = w; }
#pragma unroll
            for (int e = 0; e < 8; ++e) t8[e] = kd[8 * hh + e];
            *(LAS u32x4*)(lds + GL_KD + ct_ * 272 + sub * 32 + hh * 16) = pack8(t8);
        }
    }
    WG_BARRIER();
    {
        const int d = tid >> 2, part = tid & 3;
        const u32x4 r0 = *(const LAS u32x4*)(lds + GL_KET + d * 144 + part * 32), r1 = *(const LAS u32x4*)(lds + GL_KET + d * 144 + part * 32 + 16);
        bf16_t* kt = c.KETG + ((((size_t)DIR * NCKG + ck) * 4 + h) * 128 + d) * 64 + part * 16;
        *(u32x4*)kt = r0; *(u32x4*)(kt + 8) = r1;
    }
    {
        const int ctile = wave >> 1;
        bf16x8 Aq[4];
#pragma unroll
        for (int ks = 0; ks < 4; ++ks) Aq[ks] = *(const LAS bf16x8*)(lds + GL_QD + (16 * ctile + fr) * 272 + ks * 64 + fq * 16);
#pragma unroll
        for (int s2 = 0; s2 < 2; ++s2) {
            const int st = 2 * (wave & 1) + s2;
            f32x4 acc = {0.f, 0.f, 0.f, 0.f};
#pragma unroll
            for (int ks = 0; ks < 4; ++ks) { const bf16x8 Bk = *(const LAS bf16x8*)(lds + GL_KD + (16 * st + fr) * 272 + ks * 64 + fq * 16);
                acc = __builtin_amdgcn_mfma_f32_16x16x32_bf16(Aq[ks], Bk, acc, 0, 0, 0); }
            LAS bf16_t* att = (LAS bf16_t*)(lds + GL_ATT);
#pragma unroll
            for (int j = 0; j < 4; ++j) { const int cc = 16 * ctile + 4 * fq + j, ss = 16 * st + fr;
                const bool keep = DIR ? (cc <= ss) : (cc >= ss);
                att[cc * 72 + ss] = f2bf(keep ? acc[j] : 0.f); }
        }
    }
    WG_BARRIER();
    {
        const int r = tid >> 3, part = tid & 7;
        *(u32x4*)(c.ATTG + ((((size_t)DIR * NCKG + ck) * 4 + h) * 64 + r) * 64 + part * 8) = *(const LAS u32x4*)(lds + GL_ATT + r * 144 + part * 16);
    }
    WG_BARRIER();
}

constexpr int SQ_QD = 0, SQ_KET = 17408, SQ_ATT = 35840, SQ_VT = 45056, SQ_ST = 54272, SQ_DEC = 71680, SQ_BUF = 72192;
static_assert(2 * SQ_BUF <= LDS_BYTES - 64, "GLA sequential LDS images");
template <int DIR>
__device__ __forceinline__ void gla_seq(LAS unsigned char* lds, const GlaCtx& c, int seq, int h, int sl, int tid) {
    const int wave = __builtin_amdgcn_readfirstlane(tid >> 6), lane = tid & 63, fr = lane & 15, fq = lane >> 4;
    const int NC = c.SL / 64;
    const int ct_ = tid >> 3, sub = tid & 7;
    bf16_t* Odst = DIR ? c.OK : c.OF;
    f32x4 S[4];
#pragma unroll
    for (int i = 0; i < 4; ++i) S[i] = (f32x4){0.f, 0.f, 0.f, 0.f};
    u32x4 qdr[2][2], ker[2][2], atr[2], vraw[2]; f32x4 decr[2];
#define GLA_ISSUE(chunk_, set_) do { \
        const size_t row_ = (size_t)seq * c.SL + (size_t)(chunk_) * 64; \
        const size_t ckh_ = (((size_t)DIR * NCKG + (row_ >> 6)) * 4 + h); \
        const bf16_t* qg_ = c.QDG + ((size_t)DIR * TG + row_ + ct_) * 512 + h * 128 + sub * 16; \
        qdr[set_][0] = *(const u32x4*)qg_; qdr[set_][1] = *(const u32x4*)(qg_ + 8); \
        const bf16_t* kt_ = c.KETG + (ckh_ * 128 + (tid >> 2)) * 64 + (tid & 3) * 16; \
        ker[set_][0] = *(const u32x4*)kt_; ker[set_][1] = *(const u32x4*)(kt_ + 8); \
        atr[set_] = *(const u32x4*)(c.ATTG + (ckh_ * 64 + ct_) * 64 + sub * 8); \
        vraw[set_] = *(const u32x4*)(c.Z + (row_ + ct_) * LDZ + ZC_V + h * 256 + sl * 64 + sub * 8); \
        decr[set_] = *(const f32x4*)(c.DECG + ckh_ * 128 + (tid & 31) * 4); } while (0)
#define GLA_STAGE(set_, img_) do { \
        LAS unsigned char* B_ = lds + (img_) * SQ_BUF; \
        *(LAS u32x4*)(B_ + SQ_QD + ct_ * 272 + sub * 32) = qdr[set_][0]; *(LAS u32x4*)(B_ + SQ_QD + ct_ * 272 + sub * 32 + 16) = qdr[set_][1]; \
        *(LAS u32x4*)(B_ + SQ_KET + (tid >> 2) * 144 + (tid & 3) * 32) = ker[set_][0]; *(LAS u32x4*)(B_ + SQ_KET + (tid >> 2) * 144 + (tid & 3) * 32 + 16) = ker[set_][1]; \
        *(LAS u32x4*)(B_ + SQ_ATT + ct_ * 144 + sub * 16) = atr[set_]; \
        if (tid < 32) *(LAS f32x4*)(B_ + SQ_DEC + tid * 16) = decr[set_]; \
        { LAS bf16_t* vt_ = (LAS bf16_t*)(B_ + SQ_VT); const unsigned vw_[4] = {vraw[set_].x, vraw[set_].y, vraw[set_].z, vraw[set_].w}; \
          _Pragma("unroll") for (int e = 0; e < 4; ++e) { vt_[(sub * 8 + 2 * e) * 72 + (ct_ ^ (8 * sub))] = (bf16_t)(vw_[e] & 0xffffu); vt_[(sub * 8 + 2 * e + 1) * 72 + (ct_ ^ (8 * sub))] = (bf16_t)(vw_[e] >> 16); } } \
        _Pragma("unroll") for (int dt = 0; dt < 4; ++dt) { u32x2 w_; w_.x = cvt_pk_bf16(S[dt][0], S[dt][1]); w_.y = cvt_pk_bf16(S[dt][2], S[dt][3]); \
            *(LAS u32x2*)(B_ + SQ_ST + (16 * dt + fr) * 272 + (16 * wave + 4 * fq) * 2) = w_; } } while (0)
    GLA_ISSUE(DIR ? NC - 1 : 0, 0);
    GLA_ISSUE(DIR ? NC - 2 : 1, 1);
    GLA_STAGE(0, 0);
    GLA_ISSUE(DIR ? NC - 3 : 2, 0);
    WG_BARRIER();
#pragma unroll 1
    for (int ci2 = 0; ci2 < NC; ci2 += 2) {
#pragma unroll
      for (int ph = 0; ph < 2; ++ph) {
        const int ci = ci2 + ph;
        const int chunk = DIR ? NC - 1 - ci : ci;
        LAS unsigned char* B = lds + ph * SQ_BUF;
        {
            const int ctile = wave >> 1;
            const size_t row0 = (size_t)seq * c.SL + (size_t)chunk * 64;
            bf16x8 Aa[2], Aq[4], Bv[4][2];
#pragma unroll
            for (int dt = 0; dt < 4; ++dt)
#pragma unroll
                for (int ks = 0; ks < 2; ++ks) Bv[dt][ks] = *(const LAS bf16x8*)(B + SQ_VT + (16 * dt + fr) * 144 + (((32 * ks + 8 * fq) ^ (8 * ((2 * dt + (fr >> 3)) & 7))) * 2));
#pragma unroll
            for (int ks = 0; ks < 2; ++ks) Aa[ks] = *(const LAS bf16x8*)(B + SQ_ATT + (16 * ctile + fr) * 144 + ks * 64 + fq * 16);
#pragma unroll
            for (int ks = 0; ks < 4; ++ks) Aq[ks] = *(const LAS bf16x8*)(B + SQ_QD + (16 * ctile + fr) * 272 + ks * 64 + fq * 16);
#define GLA_OTILE(dt_) do { \
                f32x4 acc = {0.f, 0.f, 0.f, 0.f}; \
                  \
                _Pragma("unroll") for (int ks = 0; ks < 2; ++ks) acc = __builtin_amdgcn_mfma_f32_16x16x32_bf16(Bv[dt_][ks], Aa[ks], acc, 0, 0, 0); \
                _Pragma("unroll") for (int ks = 0; ks < 4; ++ks) { const bf16x8 Bs = *(const LAS bf16x8*)(B + SQ_ST + (16 * (dt_) + fr) * 272 + ks * 64 + fq * 16); \
                    acc = __builtin_amdgcn_mfma_f32_16x16x32_bf16(Bs, Aq[ks], acc, 0, 0, 0); } \
                { u32x2 w_; w_.x = cvt_pk_bf16(acc[0], acc[1]); w_.y = cvt_pk_bf16(acc[2], acc[3]); \
                  *(u32x2*)(Odst + (row0 + 16 * ctile + fr) * DRNN + h * 256 + sl * 64 + 16 * (dt_) + 4 * fq) = w_; } } while (0)
            if (wave & 1) { GLA_OTILE(2); GLA_OTILE(3); } else { GLA_OTILE(0); GLA_OTILE(1); }
#undef GLA_OTILE
            const f32x4 dec = *(const LAS f32x4*)(B + SQ_DEC + (16 * wave + 4 * fq) * 4);
            bf16x8 Ak[2];
#pragma unroll
            for (int ks = 0; ks < 2; ++ks) Ak[ks] = *(const LAS bf16x8*)(B + SQ_KET + (16 * wave + fr) * 144 + (((32 * ks + 8 * fq) ^ (8 * wave)) * 2));
#pragma unroll
            for (int dt = 0; dt < 4; ++dt) {
                S[dt] = S[dt] * dec;
#pragma unroll
                for (int ks = 0; ks < 2; ++ks) S[dt] = __builtin_amdgcn_mfma_f32_16x16x32_bf16(Ak[ks], Bv[dt][ks], S[dt], 0, 0, 0);
            }
        }
        GLA_STAGE(ph ^ 1, ph ^ 1);
        { const int cn = DIR ? (NC - 4 - ci > 0 ? NC - 4 - ci : 0) : (ci + 3 < NC - 1 ? ci + 3 : NC - 1); GLA_ISSUE(cn, ph ^ 1); }
        WG_BARRIER();
      }
    }
#undef GLA_ISSUE
#undef GLA_STAGE
}

__device__ __forceinline__ void gla_finalize(const bf16_t* Z, const bf16_t* OF, const bf16_t* OK, const float* nw, bf16_t* OB, int G, int b, int tid) {
    const int l32 = tid & 31, pr = tid >> 5;
    const f32x4 w0 = *(const f32x4*)(nw + l32 * 8), w1 = *(const f32x4*)(nw + l32 * 8 + 4);
    constexpr int NIT = TG * 4 / 16, FB = 4;
    for (int it0 = b; it0 < NIT; it0 += FB * G) {
        u32x4 ra[FB], rb[FB], rg[FB];
#pragma unroll
        for (int k = 0; k < FB; ++k) { const int it = it0 + k * G; if (it < NIT) {
            const int pair = it * 16 + pr, t = pair >> 2, hd = pair & 3; const size_t o = (size_t)t * DRNN + hd * 256 + l32 * 8;
            ra[k] = *(const u32x4*)(OF + o); rb[k] = *(const u32x4*)(OK + o); rg[k] = *(const u32x4*)(Z + (size_t)t * LDZ + ZC_OG + hd * 256 + l32 * 8); } }
#pragma unroll
        for (int k = 0; k < FB; ++k) { const int it = it0 + k * G; if (it < NIT) {
            const int pair = it * 16 + pr, t = pair >> 2, hd = pair & 3; const size_t o = (size_t)t * DRNN + hd * 256 + l32 * 8;
            float a[8], bb[8], gq[8];
            unpack8(ra[k], a); unpack8(rb[k], bb); unpack8(rg[k], gq);
            float ss = 0.f;
#pragma unroll
            for (int e = 0; e < 8; ++e) { a[e] += bb[e]; ss += a[e] * a[e]; gq[e] = gq[e] * sigmoid_f(gq[e]); }
#pragma unroll
            for (int off = 1; off < 32; off <<= 1) ss += __shfl_xor(ss, off);
            const float rs = 1.f / sqrtf(ss * (1.f / 256.f) + EPS);
            float r[8] = {a[0] * rs * w0[0] * gq[0], a[1] * rs * w0[1] * gq[1], a[2] * rs * w0[2] * gq[2], a[3] * rs * w0[3] * gq[3],
                          a[4] * rs * w1[0] * gq[4], a[5] * rs * w1[1] * gq[5], a[6] * rs * w1[2] * gq[6], a[7] * rs * w1[3] * gq[7]};
            *(u32x4*)(OB + o) = pack8(r); } }
    }
}

__device__ __forceinline__ void ff_elem(const bf16_t* U, const float* cw, const float* cb, bf16_t* HDN, int SL, int G, int b, int tid) {
    const int NIT = (TG / 32) * (DFF / 8);
    for (int it = b * 512 + tid; it < NIT; it += G * 512) {
        const int rb = it / (DFF / 8), cgp = it % (DFF / 8), r0 = rb * 32, c0 = cgp * 8;
        float w0[8], w1[8], w2[8], bb[8];
#pragma unroll
        for (int e = 0; e < 8; ++e) { w0[e] = cw[c0 + e]; w1[e] = cw[DFF + c0 + e]; w2[e] = cw[2 * DFF + c0 + e]; bb[e] = cb[c0 + e]; }
        float pv[8], cv[8], nv[8];
        if ((r0 & (SL - 1)) == 0) {
#pragma unroll
            for (int e = 0; e < 8; ++e) pv[e] = 0.f;
        } else unpack8(*(const u32x4*)(U + (size_t)(r0 - 1) * (2 * DFF) + c0), pv);
        unpack8(*(const u32x4*)(U + (size_t)r0 * (2 * DFF) + c0), cv);
        u32x4 gq[2][8], vq[2][8];
#define FF_LOAD(sb_, set_) do { _Pragma("unroll") for (int k = 0; k < 8; ++k) { const int r_ = r0 + (sb_) * 8 + k; \
            gq[set_][k] = __builtin_nontemporal_load((const u32x4*)(U + (size_t)(r_ + 1) * (2 * DFF) + c0)); \
            vq[set_][k] = __builtin_nontemporal_load((const u32x4*)(U + (size_t)r_ * (2 * DFF) + DFF + c0)); } } while (0)
#define FF_DO(sb_, set_) do { _Pragma("unroll") for (int k = 0; k < 8; ++k) { const int r = r0 + (sb_) * 8 + k; \
            unpack8(gq[set_][k], nv); \
            if (((r + 1) & (SL - 1)) == 0) { _Pragma("unroll") for (int e = 0; e < 8; ++e) nv[e] = 0.f; } \
            float uv[8]; unpack8(vq[set_][k], uv); float o[8]; \
            _Pragma("unroll") for (int e = 0; e < 8; ++e) { const float pre = bb[e] + w0[e] * pv[e] + w1[e] * cv[e] + w2[e] * nv[e]; o[e] = gelu_tanh(pre) * uv[e]; pv[e] = cv[e]; cv[e] = nv[e]; } \
            *(u32x4*)(HDN + (size_t)r * DFF + c0) = pack8(o); } } while (0)
        FF_LOAD(0, 0);
        FF_LOAD(1, 1); FF_DO(0, 0);
        FF_LOAD(2, 0); FF_DO(1, 1);
        FF_LOAD(3, 1); FF_DO(2, 0);
        FF_DO(3, 1);
#undef FF_LOAD
#undef FF_DO
    }
}

typedef const __attribute__((address_space(4))) Args* KArgs;
#define AIN(i) ((const float*)ap->in[i])
__global__ void __launch_bounds__(512, 2) mega_fwd(Args a_byval) {
    extern __shared__ __attribute__((aligned(16))) unsigned char lds_raw[];
    LAS unsigned char* lds = (LAS unsigned char*)lds_raw;
    int p, hi;
    { KArgs ap0 = (KArgs)__builtin_amdgcn_kernarg_segment_ptr(); p = ap0->ph_lo; hi = ap0->ph_hi;
      if (threadIdx.x == 0) { ((volatile LAS unsigned*)(lds + LDS_MISC))[0] = 0u; ((volatile LAS unsigned*)(lds + LDS_MISC))[1] = 0u;
          if (hi - p > 1) (void)xb_add((unsigned*)(ap0->ws + WS_CTL) + XB_XCNT(xb_xcc_id()), 1u); }
      __syncthreads(); }
    for (; p < hi; ++p) {
        int nrep = 1;
        if (REPMASK) { const int rr = (p == 0) ? 10 : (((p - 1) % PH_PER_GROUP == 0) ? 11 : (((p - 1) % PH_PER_GROUP - 1) % PH_PER_LAYER)); if ((REPMASK >> rr) & 1) nrep = 2; }
        for (int rep = 0; rep < nrep; ++rep) {
        KArgs ap = (KArgs)__builtin_amdgcn_kernarg_segment_ptr();
        asm volatile("" : "+s"(ap) :: "memory");
        int tid = threadIdx.x, b = blockIdx.x, G = gridDim.x;
        asm volatile("" : "+v"(tid), "+s"(b), "+s"(G));
        const int wave = __builtin_amdgcn_readfirstlane(tid >> 6), lane = tid & 63;
        unsigned char* ws = ap->ws;
        if (p == 0) { {
            Args a;
            a.in[I_WIN] = AIN(I_WIN); a.in[I_WUP] = AIN(I_WUP); a.in[I_WDN] = AIN(I_WDN); a.in[I_WOUT] = AIN(I_WOUT); a.in[I_WPA] = AIN(I_WPA); a.in[I_WPB] = AIN(I_WPB);
            a.in[I_BIN] = AIN(I_BIN); a.in[I_RWA] = AIN(I_RWA); a.in[I_RWX] = AIN(I_RWX); a.ws = ws;
            phase_convert(a, lds, G, b, tid); }
        } else {
            const int q = p - 1, g = q / PH_PER_GROUP, r = q % PH_PER_GROUP;
            float* X = ap->out + (size_t)g * TG * D;
            const int SL = (g == 0) ? 8192 : 2048;
            bf16_t* XN = (bf16_t*)(ws + WS_XN);
            if (r == 0) { {
                const float* src = (g == 0) ? AIN(I_XP) : AIN(I_XS) + (size_t)(g - 1) * TG * D;
                const float* gam = AIN(I_LNIG); const float* bet = AIN(I_LNIB);
                for (int m = b * 8 + wave; m < TG / LNR; m += G * 8) ln_rows<LNR>(src + (size_t)m * D, X + (size_t)m * D, XN + (size_t)m * D, nullptr, TG / LNR, gam, bet, lane); }
            } else {
                const int l = (r - 1) / PH_PER_LAYER, s = (r - 1) % PH_PER_LAYER;
                unsigned char* lw = ws + (size_t)l * LW_SIZE;
                bf16_t* Z = (bf16_t*)(ws + WS_Z);
                switch (s) {
                case 0: {
                    pg8::Gemm gm{XN, D, (const bf16_t*)(lw + LW_WIN), TG, NZ, D}; pg8::StaticOrder S; S.init(TG, NZ, G, b, WGM_BIG);
                    pg8::EpiZ E{Z, (const float*)(lw + LW_BIAS)};
                    pg8::gemm_phase(lds, gm, S, E, tid);
                } break;
                case 1: {
                    {
                        GlaCtx gc{Z, AIN(I_WG2) + (size_t)l * 2 * 16 * 512, AIN(I_BG) + (size_t)l * 2 * 512, (bf16_t*)(ws + WS_OF), (bf16_t*)(ws + WS_OK),
                                  (bf16_t*)(ws + WS_QDG), (bf16_t*)(ws + WS_KDG), (bf16_t*)(ws + WS_KETG), (float*)(ws + WS_DECG), (bf16_t*)(ws + WS_ATTG), SL};
                        for (int u = b; u < NCKG * 8; u += G) {
                            const int dir = u & 1, h = (u >> 1) & 3, ck = u >> 3;
                            if (dir) gla_pre<1>(lds, gc, ck, h, tid); else gla_pre<0>(lds, gc, ck, h, tid);
                        }
                    }
                    RgCtx rc{Z, AIN(I_CRW) + (size_t)l * 4 * DRNN, AIN(I_CRB) + (size_t)l * DRNN, (const bf16_t*)(lw + LW_RGW), AIN(I_RBA) + (size_t)l * 2 * DRNN,
                             AIN(I_RBX) + (size_t)l * 2 * DRNN, AIN(I_LAM) + (size_t)l * 2 * DRNN, (float*)(ws + WS_CARRY), (bf16_t*)(ws + WS_HA), SL};
                    rg_phase<0>(lds, rc, b, G, tid);
                } break;
                case 2: {
                    const int nseq = TG / SL, ngla = nseq * 32;
                    {
                        GlaCtx gc{Z, AIN(I_WG2) + (size_t)l * 2 * 16 * 512, AIN(I_BG) + (size_t)l * 2 * 512, (bf16_t*)(ws + WS_OF), (bf16_t*)(ws + WS_OK),
                                  (bf16_t*)(ws + WS_QDG), (bf16_t*)(ws + WS_KDG), (bf16_t*)(ws + WS_KETG), (float*)(ws + WS_DECG), (bf16_t*)(ws + WS_ATTG), SL};
                        for (int u = b; u < ngla; u += G) {
                            const int sl = (u >> 3) & 3, idx = (u & 7) | ((u >> 5) << 3), dir = idx & 1, h = (idx >> 1) & 3, seq = idx >> 3;
                            if (dir) gla_seq<1>(lds, gc, seq, h, sl, tid); else gla_seq<0>(lds, gc, seq, h, sl, tid);
                        }
                    }
                    RgCtx rc{Z, AIN(I_CRW) + (size_t)l * 4 * DRNN, AIN(I_CRB) + (size_t)l * DRNN, (const bf16_t*)(lw + LW_RGW), AIN(I_RBA) + (size_t)l * 2 * DRNN,
                             AIN(I_RBX) + (size_t)l * 2 * DRNN, AIN(I_LAM) + (size_t)l * 2 * DRNN, (float*)(ws + WS_CARRY), (bf16_t*)(ws + WS_HA), SL};
                    int w0 = 0, nw = G;
                    if (ngla <= G / 2) { w0 = ngla; nw = G - ngla; }
                    if (b >= w0) rg_phase<1>(lds, rc, b - w0, nw, tid);
                } break;
                case 3: {
                    gla_finalize(Z, (const bf16_t*)(ws + WS_OF), (const bf16_t*)(ws + WS_OK), AIN(I_NW) + (size_t)l * 256, (bf16_t*)(ws + WS_OB), G, b, tid);
                } break;
                case 4: {
                    { pg8::Gemm gm{(const bf16_t*)(ws + WS_HA), DRNN, (const bf16_t*)(lw + LW_WPA), TG, D, DRNN}; pg8::StaticOrder S; S.init(TG, D, G, b, WGM_SMALL);
                      pg8::EpiGate<false> E{Z + ZC_MA, Z + ZC_MA, nullptr}; pg8::gemm_phase(lds, gm, S, E, tid); }
                    { pg8::Gemm gm{(const bf16_t*)(ws + WS_OB), DRNN, (const bf16_t*)(lw + LW_WPB), TG, D, DRNN}; pg8::StaticOrder S; S.init(TG, D, G, b, WGM_SMALL);
                      pg8::EpiGate<true> E{Z + ZC_MA, Z + ZC_MB, Z + ZC_MA}; pg8::gemm_phase(lds, gm, S, E, tid); }
                } break;
                case 5: {
                    pg8::Gemm gm{Z + ZC_MA, LDZ, (const bf16_t*)(lw + LW_WOUT), TG, D, D}; pg8::StaticOrder S; S.init(TG, D, G, b, WGM_SMALL);
                    if (l == 0) { pg8::EpiRes<false> E{X, nullptr, nullptr, nullptr, REPMASK && rep + 1 < nrep}; pg8::gemm_phase(lds, gm, S, E, tid); }
                    else { pg8::EpiRes<true> E{X, (const float*)(ws + WS_STATS), AIN(I_LFG) + (size_t)(l - 1) * D, AIN(I_LFB) + (size_t)(l - 1) * D, REPMASK && rep + 1 < nrep}; pg8::gemm_phase(lds, gm, S, E, tid); }
                } break;
                case 6: {
                    const float* gam = AIN(I_LMG) + (size_t)l * D; const float* bet = AIN(I_LMB) + (size_t)l * D;
                    for (int m = b * 8 + wave; m < TG / LNR; m += G * 8) ln_rows<LNR>(X + (size_t)m * D, nullptr, XN + (size_t)m * D, (float*)(ws + WS_STATS) + 2 * m, TG / LNR, gam, bet, lane);
                } break;
                case 7: {
                    pg8::Gemm gm{XN, D, (const bf16_t*)(lw + LW_WUP), TG, 2 * DFF, D}; pg8::StaticOrder S; S.init(TG, 2 * DFF, G, b, WGM_BIG);
                    pg8::EpiBf16 E{(bf16_t*)(ws + WS_U), 2 * DFF}; pg8::gemm_phase(lds, gm, S, E, tid);
                } break;
                case 8: {
                    ff_elem((const bf16_t*)(ws + WS_U), AIN(I_CFW) + (size_t)l * 3 * DFF, AIN(I_CFB) + (size_t)l * DFF, (bf16_t*)(ws + WS_HDN), SL, G, b, tid);
                } break;
                case 9: {
                    pg8::Gemm gm{(const bf16_t*)(ws + WS_HDN), DFF, (const bf16_t*)(lw + LW_WDN), TG, D, DFF}; pg8::StaticOrder S; S.init(TG, D, G, b, WGM_SMALL);
                    pg8::EpiRes<true> E{X, (const float*)(ws + WS_STATS), AIN(I_LMG) + (size_t)l * D, AIN(I_LMB) + (size_t)l * D, REPMASK && rep + 1 < nrep}; pg8::gemm_phase(lds, gm, S, E, tid);
                } break;
                default: {
                    const float* gam = AIN(I_LFG) + (size_t)l * D; const float* bet = AIN(I_LFB) + (size_t)l * D;
                    for (int m = b * 8 + wave; m < TG / LNR; m += G * 8) { const bool lastl = (l + 1 >= DEPTH);
                        ln_rows<LNR>(X + (size_t)m * D, lastl ? X + (size_t)m * D : nullptr, lastl ? nullptr : XN + (size_t)m * D, (float*)(ws + WS_STATS) + 2 * m, TG / LNR, gam, bet, lane); }
                } break;
                }
            }
        }
        }
        if (p + 1 < hi) {
            if (p == 0) { __syncthreads(); cg::this_grid().sync(); }
            else { KArgs apb = (KArgs)__builtin_amdgcn_kernarg_segment_ptr(); xcd_barrier((unsigned*)(apb->ws + WS_CTL), (volatile LAS unsigned*)(lds + LDS_MISC));
                   if ((REPMASK >> 15) & 1) xcd_barrier((unsigned*)(apb->ws + WS_CTL), (volatile LAS unsigned*)(lds + LDS_MISC)); }
        }
    }
}

extern "C" void kernel_launch(void* const* d_in, const int* in_sizes, int n_in, void* d_out, int out_size, void* d_ws, size_t ws_size, hipStream_t stream) {
    static int grid = 0;
    if (grid == 0) {
        if (n_in != 27 || out_size != TALL * D || ws_size < WS_END) { fprintf(stderr, "kernel_launch: unexpected shapes n_in %d out %d ws %zu (need %zu)\n", n_in, out_size, ws_size, (size_t)WS_END); grid = -1; return; }
        int dev = 0, cus = 0, per_cu = 0;
        hipGetDevice(&dev); hipDeviceGetAttribute(&cus, hipDeviceAttributeMultiprocessorCount, dev);
        if (hipFuncSetAttribute((const void*)mega_fwd, hipFuncAttributeMaxDynamicSharedMemorySize, LDS_BYTES) != hipSuccess) { fprintf(stderr, "hipFuncSetAttribute failed\n"); grid = -1; return; }
        if (hipOccupancyMaxActiveBlocksPerMultiprocessor(&per_cu, (const void*)mega_fwd, 512, LDS_BYTES) != hipSuccess || per_cu < 1) { fprintf(stderr, "occupancy query: %d\n", per_cu); per_cu = 1; }
        (void)hipGetLastError();
        grid = cus * per_cu;
    }
    if (grid < 0) return;
    Args a{};
    for (int i = 0; i < 27; ++i) a.in[i] = (const float*)d_in[i];
    a.out = (float*)d_out; a.ws = (unsigned char*)d_ws;
#if ONE_LAUNCH
    if (hipMemsetAsync((char*)d_ws + WS_CTL, 0, CTL_BYTES, stream) != hipSuccess) { fprintf(stderr, "memset failed\n"); return; }
    a.ph_lo = 0; a.ph_hi = NPH;
    void* args[] = {&a};
    hipError_t e = hipLaunchCooperativeKernel((const void*)mega_fwd, dim3(grid), dim3(512), args, LDS_BYTES, stream);
    if (e != hipSuccess) fprintf(stderr, "cooperative launch failed: %s (grid %d)\n", hipGetErrorString(e), grid);
#else
    for (int p = 0; p < NPH; ++p) {
        a.ph_lo = p; a.ph_hi = p + 1;
        hipLaunchKernelGGL(mega_fwd, dim3(grid), dim3(512), LDS_BYTES, stream, a);
    }
#endif
}
```
